# Optimizing an MI355X kernel written in HIP

```python
import jax, jax.numpy as jnp
from jax import lax
import numpy as np

D_MODEL = 1024
BATCH = 1
SEQ = 16384
DEPTH = 1

HEAD_DIM = 64
N_MOBA_HEADS = 6
N_DIL_HEADS = 6
N_MEM_HEADS = 4
N_MEM = 256
MOBA_BLOCK = 256
MOBA_TOPK = 3
MOBA_QCHUNK = 128
DIL_PATTERNS = ((128, 1), (512, 4), (2048, 16))
DIL_BLOCK = 128
D_FF = 2816
CONV_WIDTH = 3
ROPE_THETA = 10000.0
EPS = 1e-6
N_BRANCHES = 3
MOBA_W = N_MOBA_HEADS * HEAD_DIM
DIL_W = N_DIL_HEADS * HEAD_DIM
MEM_W = N_MEM_HEADS * HEAD_DIM
IN_COLS = 3 * MOBA_W + 3 * DIL_W + MEM_W + N_BRANCHES * D_MODEL

kernel_name = "hybrid_moba_dilated_memory_convffn"


def rmsnorm(x, g):
    x32 = x.astype(jnp.float32)
    y = x32 * lax.rsqrt(jnp.mean(x32 * x32, axis=-1, keepdims=True) + EPS)
    return (y * g.astype(jnp.float32)).astype(x.dtype)


def rope(x, positions):
    half = HEAD_DIM // 2
    inv_freq = ROPE_THETA ** (-jnp.arange(half, dtype=jnp.float32) / half)
    ang = positions.astype(jnp.float32)[..., None] * inv_freq
    cos = jnp.cos(ang)[:, :, None, :]
    sin = jnp.sin(ang)[:, :, None, :]
    x1 = x[..., :half].astype(jnp.float32)
    x2 = x[..., half:].astype(jnp.float32)
    out = jnp.concatenate([x1 * cos - x2 * sin, x1 * sin + x2 * cos], axis=-1)
    return out.astype(x.dtype)


def moba_attention(q, k, v):
    B, S, H, Dh = q.shape
    s_pad = -(-S // MOBA_BLOCK) * MOBA_BLOCK
    pad = s_pad - S
    q, k, v = [jnp.pad(t, ((0, 0), (0, pad), (0, 0), (0, 0))).transpose(0, 2, 1, 3) for t in (q, k, v)]
    nb = s_pad // MOBA_BLOCK
    topk = min(MOBA_TOPK, nb)
    kb = k.reshape(B, H, nb, MOBA_BLOCK, Dh)
    vb = v.reshape(B, H, nb, MOBA_BLOCK, Dh)
    k_mean = jnp.mean(kb.astype(jnp.float32), axis=3)
    scale = Dh ** -0.5
    bi = jnp.arange(B)[:, None, None, None]
    hi = jnp.arange(H)[None, :, None, None]
    blk_ids = jnp.arange(nb)

    def one_chunk(c):
        q0 = c * MOBA_QCHUNK
        qc = lax.dynamic_slice_in_dim(q, q0, MOBA_QCHUNK, axis=2)
        qpos = q0 + jnp.arange(MOBA_QCHUNK)
        own = q0 // MOBA_BLOCK
        gate = jnp.einsum('bhqd,bhnd->bhqn', qc.astype(jnp.float32), k_mean)
        gate = jnp.where(blk_ids < own, gate, -jnp.inf)
        gval, sel = lax.top_k(gate, topk)
        sel_ok = jnp.isfinite(gval)
        k_sel = kb[bi, hi, sel]
        v_sel = vb[bi, hi, sel]
        s_sel = jnp.einsum('bhqd,bhqnjd->bhqnj', qc, k_sel).astype(jnp.float32) * scale
        s_sel = jnp.where(sel_ok[..., None], s_sel, -jnp.inf)
        s_sel = s_sel.reshape(B, H, MOBA_QCHUNK, topk * MOBA_BLOCK)
        k_own = lax.dynamic_slice_in_dim(k, own * MOBA_BLOCK, MOBA_BLOCK, axis=2)
        v_own = lax.dynamic_slice_in_dim(v, own * MOBA_BLOCK, MOBA_BLOCK, axis=2)
        kpos = own * MOBA_BLOCK + jnp.arange(MOBA_BLOCK)
        s_own = jnp.einsum('bhqd,bhjd->bhqj', qc, k_own).astype(jnp.float32) * scale
        s_own = jnp.where(kpos[None, :] <= qpos[:, None], s_own, -jnp.inf)
        p = jax.nn.softmax(jnp.concatenate([s_sel, s_own], axis=-1), axis=-1)
        p_sel = p[..., :topk * MOBA_BLOCK].reshape(B, H, MOBA_QCHUNK, topk, MOBA_BLOCK)
        p_own = p[..., topk * MOBA_BLOCK:]
        o = (jnp.einsum('bhqnj,bhqnjd->bhqd', p_sel.astype(v.dtype), v_sel)
             + jnp.einsum('bhqj,bhjd->bhqd', p_own.astype(v.dtype), v_own))
        return o

    outs = lax.map(one_chunk, jnp.arange(s_pad // MOBA_QCHUNK))
    o = outs.transpose(1, 0, 3, 2, 4).reshape(B, s_pad, H, Dh)
    return o[:, :S]


def dilated_attention(q, k, v):
    B, S, H, Dh = q.shape
    max_dil = max(d for _, d in DIL_PATTERNS)
    unit = max_dil * DIL_BLOCK
    s_pad = -(-S // unit) * unit
    pad = s_pad - S
    q, k, v = [jnp.pad(t, ((0, 0), (0, pad), (0, 0), (0, 0))) for t in (q, k, v)]
    scale = Dh ** -0.5
    outs, lses = [], []
    for window, dil in DIL_PATTERNS:
        span = window // dil
        L = s_pad // dil
        nblk = L // DIL_BLOCK

        def to_sub(t):
            return t.reshape(B, L, dil, H, Dh).transpose(0, 2, 1, 3, 4).reshape(B, dil, nblk, DIL_BLOCK, H, Dh)

        def from_sub(t):
            rest = t.shape[4:]
            t = t.reshape((B, dil, L) + rest)
            t = jnp.moveaxis(t, 1, 2)
            return t.reshape((B, s_pad) + rest)

        def with_prev(t):
            prev = jnp.pad(t[:, :, :-1], ((0, 0), (0, 0), (1, 0), (0, 0), (0, 0), (0, 0)))
            return jnp.concatenate([prev, t], axis=3)

        qs = to_sub(q)
        ks = with_prev(to_sub(k))
        vs = with_prev(to_sub(v))
        s = jnp.einsum('brnqhd,brnkhd->brnhqk', qs, ks).astype(jnp.float32) * scale
        qi = jnp.arange(DIL_BLOCK)[:, None] + DIL_BLOCK
        kj = jnp.arange(2 * DIL_BLOCK)[None, :]
        dist = qi - kj
        band = (dist >= 0) & (dist <= span)
        not_before_start = (jnp.arange(nblk) > 0)[:, None, None] | (kj >= DIL_BLOCK)[None]
        mask = band[None] & not_before_start
        s = jnp.where(mask[None, None, :, None], s, -jnp.inf)
        m = jnp.max(s, axis=-1, keepdims=True)
        p = jnp.exp(s - m)
        den = jnp.sum(p, axis=-1)
        o = jnp.einsum('brnhqk,brnkhd->brnqhd', p.astype(v.dtype), vs)
        o = o / den.transpose(0, 1, 2, 4, 3)[..., None]
        lse = (m[..., 0] + jnp.log(den)).transpose(0, 1, 2, 4, 3)
        outs.append(from_sub(o))
        lses.append(from_sub(lse))
    w = jax.nn.softmax(jnp.stack(lses, axis=0), axis=0)
    o = jnp.einsum('pbsh,pbshd->bshd', w, jnp.stack(outs, axis=0).astype(jnp.float32))
    return o[:, :S].astype(q.dtype)


def memory_attention(q, mem_k, mem_v):
    s = jnp.einsum('bshd,bmhd->bhsm', q, mem_k).astype(jnp.float32) * (HEAD_DIM ** -0.5)
    p = jax.nn.softmax(s, axis=-1)
    return jnp.einsum('bhsm,bmhd->bshd', p.astype(mem_v.dtype), mem_v)


def causal_depthwise_conv(u, w, b):
    S = u.shape[1]
    u_pad = jnp.pad(u, ((0, 0), (CONV_WIDTH - 1, 0), (0, 0)))
    y = b
    for j in range(CONV_WIDTH):
        y = y + w[j] * u_pad[:, j:j + S]
    return y


def setup_inputs(seed: int = 0) -> dict:
    key = jax.random.key(seed)
    ks = jax.random.split(key, 24)
    f32 = jnp.float32

    def nrm(k, shape, scale):
        return jax.random.normal(k, shape, f32) * scale

    def gain(k, shape):
        return 1.0 + 0.02 * jax.random.normal(k, shape, f32)

    return {
        "x": nrm(ks[0], (BATCH, SEQ, D_MODEL), 1.0),
        "mem": nrm(ks[1], (BATCH, N_MEM, D_MODEL), 1.0),
        "positions": jnp.broadcast_to(jnp.arange(SEQ, dtype=jnp.int32)[None], (BATCH, SEQ)),
        "mix_norm_g": gain(ks[2], (DEPTH, D_MODEL)),
        "mem_norm_g": gain(ks[3], (DEPTH, D_MODEL)),
        "w_in": nrm(ks[4], (DEPTH, D_MODEL, IN_COLS), D_MODEL ** -0.5),
        "moba_q_norm_g": gain(ks[5], (DEPTH, HEAD_DIM)),
        "moba_k_norm_g": gain(ks[6], (DEPTH, HEAD_DIM)),
        "dil_q_norm_g": gain(ks[7], (DEPTH, HEAD_DIM)),
        "dil_k_norm_g": gain(ks[8], (DEPTH, HEAD_DIM)),
        "mem_q_norm_g": gain(ks[9], (DEPTH, HEAD_DIM)),
        "mem_k_norm_g": gain(ks[10], (DEPTH, HEAD_DIM)),
        "w_mem_kv": nrm(ks[11], (DEPTH, D_MODEL, 2 * MEM_W), D_MODEL ** -0.5),
        "w_branch_moba": nrm(ks[12], (DEPTH, MOBA_W, D_MODEL), MOBA_W ** -0.5),
        "w_branch_dil": nrm(ks[13], (DEPTH, DIL_W, D_MODEL), DIL_W ** -0.5),
        "w_branch_mem": nrm(ks[14], (DEPTH, MEM_W, D_MODEL), MEM_W ** -0.5),
        "w_out": nrm(ks[15], (DEPTH, D_MODEL, D_MODEL), D_MODEL ** -0.5),
        "ffn_norm_g": gain(ks[16], (DEPTH, D_MODEL)),
        "w_ffn_up": nrm(ks[17], (DEPTH, D_MODEL, 2 * D_FF), D_MODEL ** -0.5),
        "ffn_conv_w": nrm(ks[18], (DEPTH, CONV_WIDTH, 2 * D_FF), CONV_WIDTH ** -0.5),
        "ffn_conv_b": nrm(ks[19], (DEPTH, 2 * D_FF), 0.01),
        "w_ffn_down": nrm(ks[20], (DEPTH, D_FF, D_MODEL), D_FF ** -0.5),
    }


def reference(x, mem, positions, mix_norm_g, mem_norm_g, w_in, moba_q_norm_g, moba_k_norm_g,
              dil_q_norm_g, dil_k_norm_g, mem_q_norm_g, mem_k_norm_g, w_mem_kv,
              w_branch_moba, w_branch_dil, w_branch_mem, w_out, ffn_norm_g,
              w_ffn_up, ffn_conv_w, ffn_conv_b, w_ffn_down):
    B, S, _ = x.shape
    split_at = [int(c) for c in np.cumsum([MOBA_W, MOBA_W, MOBA_W, DIL_W, DIL_W, DIL_W, MEM_W])]
    for l in range(DEPTH):
        h = rmsnorm(x, mix_norm_g[l])
        proj = h @ w_in[l]
        qa, ka, va, qd, kd, vd, qm, graw = jnp.split(proj, split_at, axis=-1)
        heads = lambda t, n: t.reshape(B, S, n, HEAD_DIM)
        qa = rope(rmsnorm(heads(qa, N_MOBA_HEADS), moba_q_norm_g[l]), positions)
        ka = rope(rmsnorm(heads(ka, N_MOBA_HEADS), moba_k_norm_g[l]), positions)
        va = heads(va, N_MOBA_HEADS)
        qd = rope(rmsnorm(heads(qd, N_DIL_HEADS), dil_q_norm_g[l]), positions)
        kd = rope(rmsnorm(heads(kd, N_DIL_HEADS), dil_k_norm_g[l]), positions)
        vd = heads(vd, N_DIL_HEADS)
        qm = rmsnorm(heads(qm, N_MEM_HEADS), mem_q_norm_g[l])
        gates = jax.nn.sigmoid(graw.astype(jnp.float32)).astype(x.dtype).reshape(B, S, N_BRANCHES, D_MODEL)

        mem_n = rmsnorm(mem, mem_norm_g[l])
        mkv = (mem_n @ w_mem_kv[l]).reshape(B, N_MEM, 2, N_MEM_HEADS, HEAD_DIM)
        mk = rmsnorm(mkv[:, :, 0], mem_k_norm_g[l])
        mv = mkv[:, :, 1]

        o_a = moba_attention(qa, ka, va).reshape(B, S, MOBA_W) @ w_branch_moba[l]
        o_d = dilated_attention(qd, kd, vd).reshape(B, S, DIL_W) @ w_branch_dil[l]
        o_m = memory_attention(qm, mk, mv).reshape(B, S, MEM_W) @ w_branch_mem[l]
        merged = gates[:, :, 0] * o_a + gates[:, :, 1] * o_d + gates[:, :, 2] * o_m
        x = x + merged @ w_out[l]

        h2 = rmsnorm(x, ffn_norm_g[l])
        u = causal_depthwise_conv(h2 @ w_ffn_up[l], ffn_conv_w[l], ffn_conv_b[l])
        u_gate, u_val = jnp.split(u, 2, axis=-1)
        x = x + (jax.nn.silu(u_gate) * u_val) @ w_ffn_down[l]
    return x
```

```cpp
#include <hip/hip_runtime.h>
#include <hip/hip_cooperative_groups.h>
#include <cstdio>
#include <cstdint>
namespace cg = cooperative_groups;

#define DI __device__ __forceinline__
#define LAS __attribute__((address_space(3)))
typedef unsigned short bf16_t;
typedef short bf16x8 __attribute__((ext_vector_type(8)));
typedef short s16x4 __attribute__((ext_vector_type(4)));
typedef float f32x4 __attribute__((ext_vector_type(4)));
typedef float f32x16 __attribute__((ext_vector_type(16)));
typedef unsigned u32x4 __attribute__((ext_vector_type(4)));
typedef unsigned u32x2 __attribute__((ext_vector_type(2)));
typedef float f32x2_t __attribute__((ext_vector_type(2)));
typedef __bf16 bf16x2_t __attribute__((ext_vector_type(2)));

DI int my_shfl_xor(int v, int k) { int l = (int)__lane_id(); asm volatile("" : "+v"(l)); return __builtin_amdgcn_ds_bpermute((l ^ k) << 2, v); }
DI float my_shfl_xor(float v, int k) { return __builtin_bit_cast(float, my_shfl_xor(__builtin_bit_cast(int, v), k)); }
#define __shfl_xor(v, k) my_shfl_xor((v), (k))
DI unsigned pk2(float lo, float hi) { f32x2_t v = {lo, hi}; bf16x2_t b = __builtin_convertvector(v, bf16x2_t); return __builtin_bit_cast(unsigned, b); }
DI float bf_lo(unsigned w) { return __uint_as_float(w << 16); }
DI float bf_hi(unsigned w) { return __uint_as_float(w & 0xffff0000u); }

constexpr int S = 16384, DM = 1024, INC = 5632, QKVW = 2560, GW = 3072, FF = 2816, NMEM = 256;
constexpr float EPS = 1e-6f;
constexpr float C2 = 0.125f * 1.4426950408889634f;
constexpr int C_QA = 0, C_KA = 384, C_VA = 768, C_QD = 1152, C_KD = 1536, C_VD = 1920, C_QM = 2304;
constexpr size_t HS = (size_t)S * 64;
constexpr size_t OFF_QA = 0, OFF_KA = 6 * HS, OFF_VA = 12 * HS, OFF_QD = 18 * HS, OFF_KD = 24 * HS, OFF_VD = 30 * HS, OFF_QM = 36 * HS;

constexpr size_t MiB = 1u << 20;
constexpr size_t WS_CTL = 0, CTL_ZERO_BYTES = 1 * MiB;
constexpr size_t CTL_CNT = 0;
constexpr size_t CTL_KMEAN = 4096;
constexpr size_t CTL_BAR = 512 * 1024;
constexpr size_t WS_RSTD1 = 1 * MiB;
constexpr size_t WS_SSQ2 = 1 * MiB + 128 * 1024;
constexpr size_t WS_COS = 3 * MiB, WS_SIN = 5 * MiB;
constexpr size_t WS_MEMN = 7 * MiB;
constexpr size_t WS_MKV = 7 * MiB + 512 * 1024;
constexpr size_t WS_WIN = 8 * MiB, WS_WUP = 19 * MiB, WS_WDOWN = 30 * MiB, WS_WOUT = 36 * MiB;
constexpr size_t WS_WBA = 38 * MiB, WS_WBD = 38 * MiB + 768 * 1024, WS_WBM = 41 * MiB, WS_WMKV = 40 * MiB;
constexpr size_t WS_XB = 42 * MiB;
constexpr size_t WS_PROJ = 76 * MiB;
constexpr size_t WS_GATES = 158 * MiB;
constexpr size_t WS_END = 254 * MiB;
constexpr size_t DO_SLOTO = 0;
constexpr size_t DO_SLOTL = 36 * MiB;
constexpr size_t DO_LIST = 38 * MiB;
constexpr int LIST_PER_HEAD = 516096;
DI int list_off(int n) { return n * S - 128 * n * (n + 1); }

constexpr int LDS_BYTES = 147456;
#ifndef REP_P0
#define REP_P0 1
#endif
#ifndef REP_P3
#define REP_P3 1
#endif
#ifndef REP_P4
#define REP_P4 1
#endif
#ifndef REP_P1
#define REP_P1 1
#endif
#ifndef REP_P2
#define REP_P2 1
#endif
#ifndef REP_P3B
#define REP_P3B 1
#endif
#ifndef REP_P7
#define REP_P7 1
#endif
#ifndef REP_P5
#define REP_P5 1
#endif
#ifndef REP_P6
#define REP_P6 1
#endif


namespace pg8 {
constexpr int BM = 256, BK = 64, HALF = 128, HTB = HALF * BK * 2, STAGE_BYTES = 8 * HTB, NXCD = 8, WGM = 8;
__host__ __device__ __forceinline__ int lds_byte(int r, int c) { const int st = (r >> 4) * 2 + (c >> 5), rr = r & 15, cc = c & 31, ob = rr * 64 + cc * 2; return st * 1024 + (ob ^ (((ob >> 9) & 1) << 5)); }
__host__ __device__ __forceinline__ void stage_rc(int b, int& R, int& C) { const int st = b / 1024, sb = b % 1024, swz = sb ^ (((sb >> 9) & 1) << 5); R = (st >> 1) * 16 + swz / 64; C = (st & 1) * 32 + (swz % 64) / 2; }
struct Unit { int pm, pn; };
struct Gemm { const bf16_t* A; const bf16_t* Bt; int M, N, K, lda, halo; };
struct StaticOrder {
    int nM, nN, nwg, G, c;
    DI void init(int M, int N, int G_, int c_) { nM = M / BM; nN = N / BM; nwg = nM * nN; G = G_; c = c_; }
    DI bool next(int i, Unit& u) const {
        const long L = (long)i * G + c; if (L >= nwg) return false;
        int wgid = (int)L; { const int q = nwg / NXCD, r = nwg % NXCD, xcd = wgid % NXCD, off = wgid / NXCD; wgid = (xcd < r ? xcd * (q + 1) : r * (q + 1) + (xcd - r) * q) + off; }
        const int nig = WGM * nN, gid = wgid / nig, fm = gid * WGM, gsz = (nM - fm) < WGM ? (nM - fm) : WGM;
        u.pm = fm + ((wgid % nig) % gsz); u.pn = (wgid % nig) / gsz; return true;
    }
};
struct OneUnit { int have; Unit u0; DI bool next(int i, Unit& u) const { if (i == 0 && have) { u = u0; return true; } return false; } };

template <class Epi, class Sched>
DI void gemm_phase(LAS unsigned char* lds, const Gemm g, const Sched& S, const Epi& E) {
    int tid_ = threadIdx.x; asm volatile("" : "+v"(tid_));
    const int tid = tid_, wid = __builtin_amdgcn_readfirstlane(tid >> 6), lane = tid & 63, wr = wid >> 2, wc = wid & 3, fr = lane & 15, fq = lane >> 4;
    const int K = g.K, nt = K / BK;
    unsigned voffA[2], voffB[2];
#pragma unroll
    for (int i = 0; i < 2; ++i) { int R, C; stage_rc(tid * 16 + i * 8192, R, C); const int Ra = g.halo ? (62 * (R >> 6) + 4 * (R & 15) + ((R >> 4) & 3)) : R;
        voffA[i] = (unsigned)(Ra * g.lda + C) * 2u; voffB[i] = (unsigned)(R * K + C) * 2u; }
    const size_t kstep = (size_t)(BK * 2);
    const size_t hstepA = (size_t)(g.halo ? 124 : 128) * g.lda * 2, tstepA = 2 * hstepA;
    const size_t hstepB = (size_t)HALF * K * 2, tstepB = 2 * hstepB;
    const unsigned ldsw = (unsigned)wid * 1024u;
    const int aoff = lds_byte(wr * 64 + fr, fq * 8), boff = lds_byte(wc * 32 + fr, fq * 8);
#define PG8_SA(b, h) (((b) * 2 + (h)) * HTB)
#define PG8_SB(b, h) ((4 + (b) * 2 + (h)) * HTB)
#define PG8_STAGE(bufoff, gbase, voff) do { _Pragma("unroll") for (int _i = 0; _i < 2; ++_i) \
        __builtin_amdgcn_global_load_lds((const unsigned*)((const char*)(gbase) + (voff)[_i]), (LAS unsigned*)(lds + (bufoff) + ldsw + _i * 8192), 16, 0, 0); } while (0)
#define PG8_LDA(dst, b, h) do { _Pragma("unroll") for (int m = 0; m < 4; ++m) _Pragma("unroll") for (int k = 0; k < 2; ++k) dst[m][k] = *(const LAS bf16x8*)(lds + PG8_SA(b, h) + aoff + m * 2048 + k * 1024); } while (0)
#define PG8_LDB(dst, b, h) do { _Pragma("unroll") for (int n = 0; n < 2; ++n) _Pragma("unroll") for (int k = 0; k < 2; ++k) dst[n][k] = *(const LAS bf16x8*)(lds + PG8_SB(b, h) + boff + n * 2048 + k * 1024); } while (0)
#define PG8_MMA(ai, bj, At, Bt) do { __builtin_amdgcn_s_setprio(1); _Pragma("unroll") for (int m = 0; m < 4; ++m) _Pragma("unroll") for (int n = 0; n < 2; ++n) _Pragma("unroll") for (int k = 0; k < 2; ++k) \
        acc[ai][bj][m][n] = __builtin_amdgcn_mfma_f32_16x16x32_bf16(Bt[n][k], At[m][k], acc[ai][bj][m][n], 0, 0, 0); __builtin_amdgcn_s_setprio(0); } while (0)
#define PG8_WAIT_V(n) asm volatile("s_waitcnt vmcnt(" #n ")" ::: "memory")
#define PG8_WAIT_L(n) asm volatile("s_waitcnt lgkmcnt(" #n ")" ::: "memory")
#define PG8_BAR __builtin_amdgcn_s_barrier()
#define PG8_SCHED __builtin_amdgcn_sched_barrier(0)
    Unit cur, nxt; int ui = 0;
    if (!S.next(0, cur)) return;
    f32x4 acc[2][2][4][2];
#pragma unroll
    for (int a = 0; a < 2; ++a)
#pragma unroll
        for (int b = 0; b < 2; ++b)
#pragma unroll
            for (int m = 0; m < 4; ++m)
#pragma unroll
                for (int n = 0; n < 2; ++n) acc[a][b][m][n] = (f32x4){0.f, 0.f, 0.f, 0.f};
    bf16x8 At[4][2], B0[2][2], B1[2][2];
    const char* cA = (const char*)g.A + (size_t)cur.pm * tstepA; const char* cB = (const char*)g.Bt + (size_t)cur.pn * tstepB;
    PG8_STAGE(PG8_SB(0, 0), cB, voffB); PG8_STAGE(PG8_SB(0, 1), cB + hstepB, voffB); PG8_STAGE(PG8_SA(0, 0), cA, voffA); PG8_STAGE(PG8_SA(0, 1), cA + hstepA, voffA);
    if (wr == 1) PG8_BAR;
    PG8_WAIT_V(2); PG8_BAR;
    PG8_STAGE(PG8_SB(1, 0), cB + kstep, voffB); PG8_STAGE(PG8_SA(1, 0), cA + kstep, voffA); PG8_STAGE(PG8_SB(1, 1), cB + hstepB + kstep, voffB);
    PG8_WAIT_V(6); PG8_BAR;
    for (;;) {
        const bool has_next = S.next(ui + 1, nxt);
        const char* nA = has_next ? (const char*)g.A + (size_t)nxt.pm * tstepA : cA; const char* nB = has_next ? (const char*)g.Bt + (size_t)nxt.pn * tstepB : cB;
        for (int t = 0; t < nt; t += 2) {
            const bool last = (t == nt - 2);
            const char* a1 = cA + (size_t)(t + 1) * kstep;
            const char* a2 = last ? nA : cA + (size_t)(t + 2) * kstep; const char* b2 = last ? nB : cB + (size_t)(t + 2) * kstep;
            const char* a3 = a2 + kstep; const char* b3 = b2 + kstep;
            PG8_LDB(B0, 0, 0); PG8_LDB(B1, 0, 1); PG8_SCHED; PG8_LDA(At, 0, 0); PG8_STAGE(PG8_SA(1, 1), a1 + hstepA, voffA);
            PG8_WAIT_V(8); PG8_WAIT_L(0); PG8_BAR; PG8_MMA(0, 0, At, B0); PG8_MMA(0, 1, At, B1); PG8_BAR; PG8_SCHED;
            PG8_LDA(At, 0, 1); PG8_STAGE(PG8_SB(0, 0), b2, voffB); PG8_STAGE(PG8_SB(0, 1), b2 + hstepB, voffB); PG8_STAGE(PG8_SA(0, 0), a2, voffA);
            PG8_WAIT_V(8); PG8_WAIT_L(0); PG8_BAR; PG8_MMA(1, 0, At, B0); PG8_MMA(1, 1, At, B1); PG8_BAR; PG8_SCHED;
            PG8_LDB(B0, 1, 0); PG8_LDB(B1, 1, 1); PG8_SCHED; PG8_LDA(At, 1, 0); PG8_STAGE(PG8_SA(0, 1), a2 + hstepA, voffA);
            PG8_WAIT_V(8); PG8_WAIT_L(0); PG8_BAR; PG8_MMA(0, 0, At, B0); PG8_MMA(0, 1, At, B1); PG8_BAR; PG8_SCHED;
            PG8_LDA(At, 1, 1); PG8_STAGE(PG8_SB(1, 0), b3, voffB); PG8_STAGE(PG8_SB(1, 1), b3 + hstepB, voffB); PG8_STAGE(PG8_SA(1, 0), a3, voffA);
            PG8_WAIT_V(8); PG8_WAIT_L(0); PG8_BAR; PG8_MMA(1, 0, At, B0); PG8_MMA(1, 1, At, B1); PG8_BAR; PG8_SCHED;
        }
        E(acc, cur, wr, wc, fr, fq);
        if (!has_next) break;
#pragma unroll
        for (int a = 0; a < 2; ++a)
#pragma unroll
            for (int b = 0; b < 2; ++b)
#pragma unroll
                for (int m = 0; m < 4; ++m)
#pragma unroll
                    for (int n = 0; n < 2; ++n) acc[a][b][m][n] = (f32x4){0.f, 0.f, 0.f, 0.f};
        cur = nxt; cA = nA; cB = nB; ++ui;
    }
    PG8_WAIT_V(0);
    if (wr == 0) PG8_BAR;
    PG8_BAR;
#undef PG8_SA
#undef PG8_SB
#undef PG8_STAGE
#undef PG8_LDA
#undef PG8_LDB
#undef PG8_MMA
#undef PG8_WAIT_V
#undef PG8_WAIT_L
#undef PG8_BAR
#undef PG8_SCHED
}
struct Chain3 { const bf16_t* A[3]; const bf16_t* B[3]; int K; int lda; Unit u; };
template <class EpiF>
DI void gemm_chain3(LAS unsigned char* lds, const Chain3 g, const EpiF& EF) {
    int tid_ = threadIdx.x; asm volatile("" : "+v"(tid_));
    const int tid = tid_, wid = __builtin_amdgcn_readfirstlane(tid >> 6), lane = tid & 63, wr = wid >> 2, wc = wid & 3, fr = lane & 15, fq = lane >> 4;
    unsigned voffA[2], voffB[2];
#pragma unroll
    for (int i = 0; i < 2; ++i) { int R, C; stage_rc(tid * 16 + i * 8192, R, C);
        voffA[i] = (unsigned)(R * g.lda + C) * 2u; voffB[i] = (unsigned)(R * g.K + C) * 2u; }
    const size_t kstep = (size_t)(BK * 2);
    const size_t hstepA = (size_t)128 * g.lda * 2, tstepA = 2 * hstepA;
    const size_t hstepB = (size_t)HALF * g.K * 2;
    const unsigned ldsw = (unsigned)wid * 1024u;
    const int aoff = lds_byte(wr * 64 + fr, fq * 8), boff = lds_byte(wc * 32 + fr, fq * 8);
#define PG8_SA(b, h) (((b) * 2 + (h)) * HTB)
#define PG8_SB(b, h) ((4 + (b) * 2 + (h)) * HTB)
#define PG8_STAGE(bufoff, gbase, voff) do { _Pragma("unroll") for (int _i = 0; _i < 2; ++_i) \
        __builtin_amdgcn_global_load_lds((const unsigned*)((const char*)(gbase) + (voff)[_i]), (LAS unsigned*)(lds + (bufoff) + ldsw + _i * 8192), 16, 0, 0); } while (0)
#define PG8_LDA(dst, b, h) do { _Pragma("unroll") for (int m = 0; m < 4; ++m) _Pragma("unroll") for (int k = 0; k < 2; ++k) dst[m][k] = *(const LAS bf16x8*)(lds + PG8_SA(b, h) + aoff + m * 2048 + k * 1024); } while (0)
#define PG8_LDB(dst, b, h) do { _Pragma("unroll") for (int n = 0; n < 2; ++n) _Pragma("unroll") for (int k = 0; k < 2; ++k) dst[n][k] = *(const LAS bf16x8*)(lds + PG8_SB(b, h) + boff + n * 2048 + k * 1024); } while (0)
#define PG8_MMA(ai, bj, At, Bt) do { __builtin_amdgcn_s_setprio(1); _Pragma("unroll") for (int m = 0; m < 4; ++m) _Pragma("unroll") for (int n = 0; n < 2; ++n) _Pragma("unroll") for (int k = 0; k < 2; ++k) \
        acc[ai][bj][m][n] = __builtin_amdgcn_mfma_f32_16x16x32_bf16(Bt[n][k], At[m][k], acc[ai][bj][m][n], 0, 0, 0); __builtin_amdgcn_s_setprio(0); } while (0)
#define PG8_WAIT_V(n) asm volatile("s_waitcnt vmcnt(" #n ")" ::: "memory")
#define PG8_WAIT_L(n) asm volatile("s_waitcnt lgkmcnt(" #n ")" ::: "memory")
#define PG8_BAR __builtin_amdgcn_s_barrier()
#define PG8_SCHED __builtin_amdgcn_sched_barrier(0)
    const Unit cur = g.u; int ui = 0;
    f32x4 acc[2][2][4][2];
#pragma unroll
    for (int a = 0; a < 2; ++a)
#pragma unroll
        for (int b = 0; b < 2; ++b)
#pragma unroll
            for (int m = 0; m < 4; ++m)
#pragma unroll
                for (int n = 0; n < 2; ++n) acc[a][b][m][n] = (f32x4){0.f, 0.f, 0.f, 0.f};
    bf16x8 At[4][2], B0[2][2], B1[2][2];
    const char* cA = (const char*)g.A[0] + (size_t)cur.pm * tstepA; const char* cB = (const char*)g.B[0] + (size_t)cur.pn * 2 * hstepB;
    PG8_STAGE(PG8_SB(0, 0), cB, voffB); PG8_STAGE(PG8_SB(0, 1), cB + hstepB, voffB); PG8_STAGE(PG8_SA(0, 0), cA, voffA); PG8_STAGE(PG8_SA(0, 1), cA + hstepA, voffA);
    if (wr == 1) PG8_BAR;
    PG8_WAIT_V(2); PG8_BAR;
    PG8_STAGE(PG8_SB(1, 0), cB + kstep, voffB); PG8_STAGE(PG8_SA(1, 0), cA + kstep, voffA); PG8_STAGE(PG8_SB(1, 1), cB + hstepB + kstep, voffB);
    PG8_WAIT_V(6); PG8_BAR;
    for (;;) {
        const bool has_next = ui < 2; const int un = has_next ? ui + 1 : ui;
        const bf16_t* An = un == 0 ? g.A[0] : (un == 1 ? g.A[1] : g.A[2]); const bf16_t* Bn = un == 0 ? g.B[0] : (un == 1 ? g.B[1] : g.B[2]);
        const int nt = g.K / BK;
        const char* nA = has_next ? (const char*)An + (size_t)cur.pm * tstepA : cA; const char* nB = has_next ? (const char*)Bn + (size_t)cur.pn * 2 * hstepB : cB;
        for (int t = 0; t < nt; t += 2) {
            const bool last = (t == nt - 2);
            const char* a1 = cA + (size_t)(t + 1) * kstep;
            const char* a2 = last ? nA : cA + (size_t)(t + 2) * kstep; const char* b2 = last ? nB : cB + (size_t)(t + 2) * kstep;
            const char* a3 = a2 + kstep; const char* b3 = b2 + kstep;
            PG8_LDB(B0, 0, 0); PG8_LDB(B1, 0, 1); PG8_SCHED; PG8_LDA(At, 0, 0); PG8_STAGE(PG8_SA(1, 1), a1 + hstepA, voffA);
            PG8_WAIT_V(8); PG8_WAIT_L(0); PG8_BAR; PG8_MMA(0, 0, At, B0); PG8_MMA(0, 1, At, B1); PG8_BAR; PG8_SCHED;
            PG8_LDA(At, 0, 1); PG8_STAGE(PG8_SB(0, 0), b2, voffB); PG8_STAGE(PG8_SB(0, 1), b2 + hstepB, voffB); PG8_STAGE(PG8_SA(0, 0), a2, voffA);
            PG8_WAIT_V(8); PG8_WAIT_L(0); PG8_BAR; PG8_MMA(1, 0, At, B0); PG8_MMA(1, 1, At, B1); PG8_BAR; PG8_SCHED;
            PG8_LDB(B0, 1, 0); PG8_LDB(B1, 1, 1); PG8_SCHED; PG8_LDA(At, 1, 0); PG8_STAGE(PG8_SA(0, 1), a2 + hstepA, voffA);
            PG8_WAIT_V(8); PG8_WAIT_L(0); PG8_BAR; PG8_MMA(0, 0, At, B0); PG8_MMA(0, 1, At, B1); PG8_BAR; PG8_SCHED;
            PG8_LDA(At, 1, 1); PG8_STAGE(PG8_SB(1, 0), b3, voffB); PG8_STAGE(PG8_SB(1, 1), b3 + hstepB, voffB); PG8_STAGE(PG8_SA(1, 0), a3, voffA);
            PG8_WAIT_V(8); PG8_WAIT_L(0); PG8_BAR; PG8_MMA(1, 0, At, B0); PG8_MMA(1, 1, At, B1); PG8_BAR; PG8_SCHED;
        }
        if (wr == 0) PG8_BAR;
        EF(acc, ui, cur, wr, wc, fr, fq);
        if (!has_next) break;
        cA = nA; cB = nB; ++ui;
        if (wr == 1) PG8_BAR;
    }
    PG8_WAIT_V(0);
    PG8_BAR;
#undef PG8_SA
#undef PG8_SB
#undef PG8_STAGE
#undef PG8_LDA
#undef PG8_LDB
#undef PG8_MMA
#undef PG8_WAIT_V
#undef PG8_WAIT_L
#undef PG8_BAR
#undef PG8_SCHED
}
}
using pg8::Unit;

struct Params {
    const float* x; const float* mem; const int* pos;
    const float *mix_g, *memn_g, *w_in, *aq_g, *ak_g, *dq_g, *dk_g, *eq_g, *ek_g, *w_memkv, *w_ba, *w_bd, *w_bm, *w_out, *ffn_g, *w_up, *conv_w, *conv_b, *w_down;
    float* out; unsigned char* ws;
};

struct EpiIn {
    int mode;
    bf16_t* proj; int ldp; bf16_t* gates; const float* rstd; const float* cosT; const float* sinT;
    const float *g_qa, *g_ka, *g_qd, *g_kd, *g_qm; float* kmean;
    DI void operator()(const f32x4 (&acc)[2][2][4][2], const Unit& u, int wr, int wc, int fr, int fq) const {
        const int cb = u.pn * 256 + wc * 64;
        const int row0 = u.pm * 256 + wr * 64 + fr;
        int kind; const float* gain = nullptr; float qs = 1.f; bool isk = false; bf16_t* ob = proj; int ldc = ldp; int oc = cb; int khead = 0;
        if (mode == 0) {
            if (cb < C_QM) { const int seg = cb / 384, hh = (cb - seg * 384) >> 6;
                if (seg == 0) { kind = 0; gain = g_qa; qs = C2; } else if (seg == 1) { kind = 0; gain = g_ka; isk = true; khead = hh; }
                else if (seg == 3) { kind = 0; gain = g_qd; qs = C2; } else if (seg == 4) { kind = 0; gain = g_kd; } else kind = 2;
                ob = proj + (size_t)(seg * 6 + hh) * HS; ldc = 64; oc = 0; }
            else if (cb < QKVW) { kind = 1; gain = g_qm; qs = C2; ob = proj + OFF_QM + (size_t)((cb - C_QM) >> 6) * HS; ldc = 64; oc = 0; }
            else { kind = 3; ob = gates; ldc = GW; oc = cb - QKVW; }
        } else { if (u.pn == 0) { kind = 1; gain = g_qa; } else kind = 2; }
        f32x4 gv[2][2];
#pragma unroll
        for (int bj = 0; bj < 2; ++bj)
#pragma unroll
            for (int n = 0; n < 2; ++n) gv[bj][n] = (kind <= 1) ? *(const f32x4*)(gain + 32 * bj + 8 * fq + 4 * n) : (f32x4){1.f, 1.f, 1.f, 1.f};
        f32x4 cs[2][2];
#pragma unroll
        for (int bj = 0; bj < 2; ++bj) { cs[bj][0] = (f32x4){0.f, 0.f, 0.f, 0.f}; cs[bj][1] = cs[bj][0]; }
#pragma unroll
        for (int ai = 0; ai < 2; ++ai)
#pragma unroll
            for (int m = 0; m < 4; ++m) {
                const int row = row0 + ai * 128 + m * 16;
                const float rs = rstd ? rstd[row] : 1.f;
                f32x4 v[2][2];
#pragma unroll
                for (int bj = 0; bj < 2; ++bj)
#pragma unroll
                    for (int n = 0; n < 2; ++n) v[bj][n] = acc[ai][bj][m][n] * rs;
                if (kind <= 1) {
                    float ss = 0.f;
#pragma unroll
                    for (int bj = 0; bj < 2; ++bj)
#pragma unroll
                        for (int n = 0; n < 2; ++n) { const f32x4 t = v[bj][n]; ss += (t[0] * t[0] + t[1] * t[1]) + (t[2] * t[2] + t[3] * t[3]); }
                    ss += __shfl_xor(ss, 16); ss += __shfl_xor(ss, 32);
                    const float inv = rsqrtf(ss * (1.f / 64.f) + EPS);
#pragma unroll
                    for (int bj = 0; bj < 2; ++bj)
#pragma unroll
                        for (int n = 0; n < 2; ++n) v[bj][n] = v[bj][n] * inv * gv[bj][n];
                    if (kind == 0) {
#pragma unroll
                        for (int n = 0; n < 2; ++n) {
                            const f32x4 c = *(const f32x4*)(cosT + (size_t)row * 32 + 8 * fq + 4 * n), s = *(const f32x4*)(sinT + (size_t)row * 32 + 8 * fq + 4 * n);
                            const f32x4 x1 = v[0][n], x2 = v[1][n];
                            v[0][n] = x1 * c - x2 * s; v[1][n] = x1 * s + x2 * c;
                        }
                    }
#pragma unroll
                    for (int bj = 0; bj < 2; ++bj)
#pragma unroll
                        for (int n = 0; n < 2; ++n) v[bj][n] = v[bj][n] * qs;
                    if (isk) {
#pragma unroll
                        for (int bj = 0; bj < 2; ++bj)
#pragma unroll
                            for (int n = 0; n < 2; ++n) cs[bj][n] += v[bj][n];
                    }
                } else if (kind == 3) {
#pragma unroll
                    for (int bj = 0; bj < 2; ++bj)
#pragma unroll
                        for (int n = 0; n < 2; ++n)
#pragma unroll
                            for (int j = 0; j < 4; ++j) v[bj][n][j] = fmaxf(__builtin_amdgcn_rcpf(1.f + __expf(-v[bj][n][j])), 1e-20f);
                }
                bf16_t* rp = ob + (size_t)row * ldc + oc + 8 * fq;
#pragma unroll
                for (int bj = 0; bj < 2; ++bj) { u32x4 w; w.x = pk2(v[bj][0][0], v[bj][0][1]); w.y = pk2(v[bj][0][2], v[bj][0][3]); w.z = pk2(v[bj][1][0], v[bj][1][1]); w.w = pk2(v[bj][1][2], v[bj][1][3]);
                    *(u32x4*)(rp + 32 * bj) = w; }
            }
        if (isk && kmean) {
#pragma unroll
            for (int bj = 0; bj < 2; ++bj)
#pragma unroll
                for (int n = 0; n < 2; ++n)
#pragma unroll
                    for (int j = 0; j < 4; ++j) { float t = cs[bj][n][j]; t += __shfl_xor(t, 1); t += __shfl_xor(t, 2); t += __shfl_xor(t, 4); t += __shfl_xor(t, 8);
                        if (fr == 0) atomicAdd(kmean + ((size_t)(khead * 64 + u.pm) * 64 + 32 * bj + 8 * fq + 4 * n + j), t * (1.f / 256.f)); }
        }
    }
};

struct EpiGate {
    bf16_t* merged; const bf16_t* gates; int gi; int first;
    DI void operator()(const f32x4 (&acc)[2][2][4][2], const Unit& u, int wr, int wc, int fr, int fq) const {
        const int row0 = u.pm * 256 + wr * 64 + fr, col = u.pn * 256 + wc * 64 + 8 * fq;
#pragma unroll
        for (int ai = 0; ai < 2; ++ai)
#pragma unroll
            for (int m = 0; m < 4; ++m) { const int row = row0 + ai * 128 + m * 16;
#pragma unroll
                for (int bj = 0; bj < 2; ++bj) {
                    const u32x4 g = *(const u32x4*)(gates + (size_t)row * GW + gi * 1024 + col + 32 * bj);
                    bf16_t* mp = merged + (size_t)row * DM + col + 32 * bj;
                    float o[8];
                    o[0] = acc[ai][bj][m][0][0] * bf_lo(g.x); o[1] = acc[ai][bj][m][0][1] * bf_hi(g.x); o[2] = acc[ai][bj][m][0][2] * bf_lo(g.y); o[3] = acc[ai][bj][m][0][3] * bf_hi(g.y);
                    o[4] = acc[ai][bj][m][1][0] * bf_lo(g.z); o[5] = acc[ai][bj][m][1][1] * bf_hi(g.z); o[6] = acc[ai][bj][m][1][2] * bf_lo(g.w); o[7] = acc[ai][bj][m][1][3] * bf_hi(g.w);
                    if (!first) { const u32x4 p = *(const u32x4*)mp;
                        o[0] += bf_lo(p.x); o[1] += bf_hi(p.x); o[2] += bf_lo(p.y); o[3] += bf_hi(p.y); o[4] += bf_lo(p.z); o[5] += bf_hi(p.z); o[6] += bf_lo(p.w); o[7] += bf_hi(p.w); }
                    u32x4 w; w.x = pk2(o[0], o[1]); w.y = pk2(o[2], o[3]); w.z = pk2(o[4], o[5]); w.w = pk2(o[6], o[7]);
                    *(u32x4*)mp = w; } }
    }
};

struct EpiGate3 { bf16_t* merged_; const bf16_t* gates_;
    DI void operator()(f32x4 (&acc)[2][2][4][2], int i, const Unit& u, int wr, int wc, int fr, int fq) const {
        const int row0 = u.pm * 256 + wr * 64 + fr, col = u.pn * 256 + wc * 64 + 8 * fq;
#pragma unroll
        for (int ai = 0; ai < 2; ++ai)
#pragma unroll
            for (int m = 0; m < 4; ++m) { const int row = row0 + ai * 128 + m * 16;
#pragma unroll
                for (int bj = 0; bj < 2; ++bj) {
                    const bf16_t* gp = gates_ + (size_t)row * GW + i * 1024 + col + 32 * bj;
                    const u32x4 ga = *(const u32x4*)gp;
#define G_LO(w) bf_lo(w)
#define G_HI(w) bf_hi(w)
                    if (i < 2) { const u32x4 gb = *(const u32x4*)(gp + 1024);
                        acc[ai][bj][m][0][0] *= G_LO(ga.x) * __builtin_amdgcn_rcpf(G_LO(gb.x)); acc[ai][bj][m][0][1] *= G_HI(ga.x) * __builtin_amdgcn_rcpf(G_HI(gb.x));
                        acc[ai][bj][m][0][2] *= G_LO(ga.y) * __builtin_amdgcn_rcpf(G_LO(gb.y)); acc[ai][bj][m][0][3] *= G_HI(ga.y) * __builtin_amdgcn_rcpf(G_HI(gb.y));
                        acc[ai][bj][m][1][0] *= G_LO(ga.z) * __builtin_amdgcn_rcpf(G_LO(gb.z)); acc[ai][bj][m][1][1] *= G_HI(ga.z) * __builtin_amdgcn_rcpf(G_HI(gb.z));
                        acc[ai][bj][m][1][2] *= G_LO(ga.w) * __builtin_amdgcn_rcpf(G_LO(gb.w)); acc[ai][bj][m][1][3] *= G_HI(ga.w) * __builtin_amdgcn_rcpf(G_HI(gb.w));
                    } else {
                        u32x4 w;
                        w.x = pk2(acc[ai][bj][m][0][0] * G_LO(ga.x), acc[ai][bj][m][0][1] * G_HI(ga.x)); w.y = pk2(acc[ai][bj][m][0][2] * G_LO(ga.y), acc[ai][bj][m][0][3] * G_HI(ga.y));
                        w.z = pk2(acc[ai][bj][m][1][0] * G_LO(ga.z), acc[ai][bj][m][1][1] * G_HI(ga.z)); w.w = pk2(acc[ai][bj][m][1][2] * G_LO(ga.w), acc[ai][bj][m][1][3] * G_HI(ga.w));
                        *(u32x4*)(merged_ + (size_t)row * DM + col + 32 * bj) = w; }
#undef G_LO
#undef G_HI
                    asm volatile("" ::: "memory");
                } }
    }
};

struct EpiRes1 {
    const float* x; float* x1; bf16_t* x1b; float* ssq;
    DI void operator()(const f32x4 (&acc)[2][2][4][2], const Unit& u, int wr, int wc, int fr, int fq) const {
        const int row0 = u.pm * 256 + wr * 64 + fr, col = u.pn * 256 + wc * 64 + 8 * fq;
#pragma unroll
        for (int ai = 0; ai < 2; ++ai)
#pragma unroll
            for (int m = 0; m < 4; ++m) { const int row = row0 + ai * 128 + m * 16; float ss = 0.f;
#pragma unroll
                for (int bj = 0; bj < 2; ++bj) { f32x4 v[2];
#pragma unroll
                    for (int n = 0; n < 2; ++n) { const size_t off = (size_t)row * DM + col + 32 * bj + 4 * n; v[n] = *(const f32x4*)(x + off) + acc[ai][bj][m][n];
                        ss += (v[n][0] * v[n][0] + v[n][1] * v[n][1]) + (v[n][2] * v[n][2] + v[n][3] * v[n][3]); }
                    u32x4 w; w.x = pk2(v[0][0], v[0][1]); w.y = pk2(v[0][2], v[0][3]); w.z = pk2(v[1][0], v[1][1]); w.w = pk2(v[1][2], v[1][3]);
                    *(u32x4*)(x1b + (size_t)row * DM + col + 32 * bj) = w; }
                ss += __shfl_xor(ss, 16); ss += __shfl_xor(ss, 32);
                if (fq == 0) ssq[(size_t)row * 16 + u.pn * 4 + wc] = ss; }
    }
};

struct EpiRes2 {
    float* out; const bf16_t* x1b; int store;
    DI void operator()(const f32x4 (&acc)[2][2][4][2], const Unit& u, int wr, int wc, int fr, int fq) const {
        const int row0 = u.pm * 256 + wr * 64 + fr, col = u.pn * 256 + wc * 64 + 8 * fq;
#pragma unroll
        for (int ai = 0; ai < 2; ++ai)
#pragma unroll
            for (int m = 0; m < 4; ++m) { const int row = row0 + ai * 128 + m * 16;
#pragma unroll
                for (int bj = 0; bj < 2; ++bj) { const size_t off = (size_t)row * DM + col + 32 * bj; const u32x4 r = *(const u32x4*)(x1b + off);
                    f32x4 v0 = acc[ai][bj][m][0], v1 = acc[ai][bj][m][1];
                    v0[0] += bf_lo(r.x); v0[1] += bf_hi(r.x); v0[2] += bf_lo(r.y); v0[3] += bf_hi(r.y); v1[0] += bf_lo(r.z); v1[1] += bf_hi(r.z); v1[2] += bf_lo(r.w); v1[3] += bf_hi(r.w);
                    if (store) { *(f32x4*)(out + off) = v0; *(f32x4*)(out + off + 4) = v1; } } }
    }
};

DI float dpp_ror1(float v) { return __builtin_bit_cast(float, __builtin_amdgcn_update_dpp(0, __builtin_bit_cast(int, v), 0x121, 0xf, 0xf, false)); }
DI float dpp_ror2(float v) { return __builtin_bit_cast(float, __builtin_amdgcn_update_dpp(0, __builtin_bit_cast(int, v), 0x122, 0xf, 0xf, false)); }

struct EpiConv {
    bf16_t* act; const float* ssq; const float* cw; const float* cbias;
    DI void operator()(const f32x4 (&acc)[2][2][4][2], const Unit& u, int wr, int wc, int fr, int fq) const {
        const int ca = u.pn * 128 + wc * 32 + 8 * fq;
#pragma unroll
        for (int ai = 0; ai < 2; ++ai) {
            const int tok0 = u.pm * 248 + 62 * (2 * ai + wr) + 4 * fr - 2;
            float rs[4];
#pragma unroll
            for (int m = 0; m < 4; ++m) { const int tok = tok0 + m; float r = 0.f;
                const bool okr = (tok >= 0 && tok < S);
                const f32x4 a = okr ? *(const f32x4*)(ssq + (size_t)tok * 16 + 4 * fq) : (f32x4){0.f, 0.f, 0.f, 0.f};
                float t = (a[0] + a[1]) + (a[2] + a[3]); t += __shfl_xor(t, 16); t += __shfl_xor(t, 32);
                if (okr) r = rsqrtf(t * (1.f / 1024.f) + EPS);
                rs[m] = r; }
            __builtin_amdgcn_sched_barrier(0);
            unsigned pkd[4][4];
#pragma unroll
            for (int n = 0; n < 2; ++n) {
                f32x4 w0[2], w1[2], w2[2], bb[2];
#pragma unroll
                for (int bj = 0; bj < 2; ++bj) { const int c = bj * FF + ca + 4 * n;
                    w0[bj] = *(const f32x4*)(cw + c); w1[bj] = *(const f32x4*)(cw + 2 * FF + c); w2[bj] = *(const f32x4*)(cw + 4 * FF + c); bb[bj] = *(const f32x4*)(cbias + c); }
                asm volatile("" : "+v"(w0[0]), "+v"(w1[0]), "+v"(w2[0]), "+v"(bb[0]), "+v"(w0[1]), "+v"(w1[1]), "+v"(w2[1]), "+v"(bb[1]));
#pragma unroll
                for (int jp = 0; jp < 2; ++jp) {
                    float av[4][2];
#pragma unroll
                    for (int jj = 0; jj < 2; ++jj) { const int j = 2 * jp + jj;
                        float y[2][4];
#pragma unroll
                        for (int bj = 0; bj < 2; ++bj) {
                            float X[4], t2, t3;
#pragma unroll
                            for (int m = 0; m < 4; ++m) X[m] = acc[ai][bj][m][n][j] * rs[m];
                            asm volatile("s_nop 1\n\t"
                                         "v_mov_b32_dpp %0, %2 row_shr:1 row_mask:0xf bank_mask:0xf\n\t"
                                         "v_mov_b32_dpp %1, %3 row_shr:1 row_mask:0xf bank_mask:0xf"
                                         : "=&v"(t2), "=&v"(t3) : "v"(X[2]), "v"(X[3]));
                            const float a0 = w0[bj][j], a1 = w1[bj][j], a2 = w2[bj][j], bv = bb[bj][j];
                            y[bj][0] = bv + a0 * t2 + a1 * t3 + a2 * X[0];
                            y[bj][1] = bv + a0 * t3 + a1 * X[0] + a2 * X[1];
                            y[bj][2] = bv + a0 * X[0] + a1 * X[1] + a2 * X[2];
                            y[bj][3] = bv + a0 * X[1] + a1 * X[2] + a2 * X[3];
                        }
#pragma unroll
                        for (int m = 0; m < 4; ++m) { const float gt = y[0][m]; av[m][jj] = gt * __builtin_amdgcn_rcpf(1.f + __expf(-gt)) * y[1][m];
                            asm volatile("" : "+v"(av[m][jj])); }
                    }
#pragma unroll
                    for (int m = 0; m < 4; ++m) { pkd[m][2 * n + jp] = pk2(av[m][0], av[m][1]); asm volatile("" : "+v"(pkd[m][2 * n + jp])); }
                    __builtin_amdgcn_sched_barrier(0);
                }
                asm volatile("" ::: "memory");
            }
#pragma unroll
            for (int m = 0; m < 4; ++m) { const int tok = tok0 + m;
                if ((4 * fr + m) >= 2 && tok < S) { u32x4 w; w.x = pkd[m][0]; w.y = pkd[m][1]; w.z = pkd[m][2]; w.w = pkd[m][3]; *(u32x4*)(act + (size_t)tok * FF + ca) = w; } }
        }
    }
};

DI int perm_generic(int c) { const int u = c >> 8, cl = c & 255, wc = cl >> 6, bj = (cl >> 5) & 1, fq = (cl >> 3) & 3, n = (cl >> 2) & 1, j = cl & 3; return (u << 8) + 128 * bj + 32 * wc + 16 * n + 4 * fq + j; }
DI int perm_up(int c) { const int bj = c >= FF ? 1 : 0, a = c - FF * bj, pn = a >> 7, al = a & 127, wc = al >> 5, fq = (al >> 3) & 3, n = (al >> 2) & 1, j = al & 3; return (pn << 8) + 128 * bj + 32 * wc + 16 * n + 4 * fq + j; }
DI float wave_sum(float v) {
#pragma unroll
    for (int o = 1; o < 64; o <<= 1) v += __shfl_xor(v, o);
    return v; }
DI float wave_max(float v) {
#pragma unroll
    for (int o = 1; o < 64; o <<= 1) v = fmaxf(v, __shfl_xor(v, o));
    return v; }
DI void p0_transpose_item(const float* W, int K, int N, const float* gain, bf16_t* WT, int up, LAS float* scr, int item, int lane, int ldt = 0) {
    const int nblk = N / 32, kb = item / nblk, nb = item % nblk, k0 = 64 * kb, n0 = 32 * nb;
    const int c4 = lane & 7, r0 = lane >> 3;
    f32x4 w[8];
#pragma unroll
    for (int i = 0; i < 8; ++i) w[i] = *(const f32x4*)(W + (size_t)(k0 + r0 + 8 * i) * N + n0 + 4 * c4);
#pragma unroll
    for (int i = 0; i < 8; ++i) { const int kk = r0 + 8 * i; f32x4 v = w[i]; if (gain) v = v * gain[k0 + kk];
        LAS float* d = scr + kk * 33 + 4 * c4; d[0] = v[0]; d[1] = v[1]; d[2] = v[2]; d[3] = v[3]; }
    asm volatile("s_waitcnt lgkmcnt(0)" ::: "memory");
    const int c = lane & 7;
#pragma unroll
    for (int j = 0; j < 4; ++j) { const int n = (lane >> 3) + 8 * j; const LAS float* s = scr + (8 * c) * 33 + n;
        u32x4 o; o.x = pk2(s[0 * 33], s[1 * 33]); o.y = pk2(s[2 * 33], s[3 * 33]); o.z = pk2(s[4 * 33], s[5 * 33]); o.w = pk2(s[6 * 33], s[7 * 33]);
        const int rowp = up ? perm_up(n0 + n) : perm_generic(n0 + n);
        *(u32x4*)(WT + (size_t)rowp * (ldt ? ldt : K) + k0 + 8 * c) = o; }
    asm volatile("s_waitcnt lgkmcnt(0)" ::: "memory");
}

#define MFMA32(a, b, c) __builtin_amdgcn_mfma_f32_32x32x16_bf16((a), (b), (c), 0, 0, 0)
DI int crow(int i, int h) { return (i & 3) + 8 * (i >> 2) + 4 * h; }
DI s16x4 vtr(const LAS unsigned char* p) { return __builtin_bit_cast(s16x4, __builtin_amdgcn_ds_read_tr16_b64_v4i16((LAS s16x4*)p)); }
constexpr int KP = 144;

DI void pv_tile(const float (&p)[16], const LAS unsigned char* vt, f32x16 (&o)[2], int lane) {
    const int h = lane >> 5, i16 = lane & 15, q = i16 >> 2, pp = i16 & 3, blk = (lane >> 4) & 1;
    bf16x8 pb[2];
#pragma unroll
    for (int sp = 0; sp < 2; ++sp) { u32x4 w; w.x = pk2(p[8 * sp + 0], p[8 * sp + 1]); w.y = pk2(p[8 * sp + 2], p[8 * sp + 3]); w.z = pk2(p[8 * sp + 4], p[8 * sp + 5]); w.w = pk2(p[8 * sp + 6], p[8 * sp + 7]); pb[sp] = __builtin_bit_cast(bf16x8, w); }
#pragma unroll
    for (int dh = 0; dh < 2; ++dh)
#pragma unroll
        for (int sp = 0; sp < 2; ++sp) {
            const LAS unsigned char* a0 = vt + (16 * sp + 4 * h + q) * KP + 2 * (32 * dh + 16 * blk) + 8 * pp;
            const s16x4 lo = vtr(a0), hi = vtr(a0 + 8 * KP);
            const bf16x8 vf = __builtin_shufflevector(lo, hi, 0, 1, 2, 3, 4, 5, 6, 7);
            o[dh] = MFMA32(vf, pb[sp], o[dh]);
        }
}

DI float softmax_bound(const float* gq, const float* gk, int lane) { const float a = wave_max(fabsf(gq[lane])), b = wave_max(fabsf(gk[lane])); const float r = 64.f * a * b * C2;
    return __builtin_bit_cast(float, __builtin_amdgcn_readfirstlane(__builtin_bit_cast(int, r))); }

struct BAUnit { const bf16_t* Kg; const bf16_t* Vg; int kpitch; const bf16_t* Q; int qpitch; int q0; const unsigned* list; int count; int head; int nvalid; bf16_t* O; int opitch; };
struct BAPref { u32x4 k[4], v[4]; bf16x8 qf[4]; unsigned ent; int qrow; bool valid; };
template <int MODE>
DI void ba_issue(BAPref& f, const BAUnit& u, int tid, int wave, int r32, int h) {
#pragma unroll
    for (int i = 0; i < 4; ++i) { const int c = tid + 512 * i, row = c >> 3, cc = c & 7;
        f.k[i] = *(const u32x4*)(u.Kg + (size_t)row * u.kpitch + 8 * cc); f.v[i] = *(const u32x4*)(u.Vg + (size_t)row * u.kpitch + 8 * cc); }
    f.ent = 0u; f.valid = true;
    if (MODE == 1) { const int idx = 32 * wave + r32; f.valid = idx < u.count; f.ent = f.valid ? u.list[idx] : 0u; f.qrow = (int)(f.ent >> 2); }
    else f.qrow = u.q0 + 32 * wave + r32;
#pragma unroll
    for (int s = 0; s < 4; ++s) f.qf[s] = *(const bf16x8*)(u.Q + (size_t)f.qrow * u.qpitch + 16 * s + 8 * h);
}
template <int MODE, class NextF>
DI void block_attn_loop(LAS unsigned char* lds, const NextF& next, float negM, bf16_t* slotO, float* slotL, bool do_store) {
    int tid_ = threadIdx.x; asm volatile("" : "+v"(tid_));
    const int tid = tid_, lane = tid & 63, wave = __builtin_amdgcn_readfirstlane(tid >> 6), r32 = lane & 31, h = lane >> 5;
    LAS unsigned char* Kl = lds; LAS unsigned char* Vl = lds + 256 * KP;
    BAUnit cur, nxt; int ui = 0;
    if (!next(0, cur)) return;
    BAPref f; ba_issue<MODE>(f, cur, tid, wave, r32, h);
    f32x16 negm;
#pragma unroll
    for (int i = 0; i < 16; ++i) negm[i] = negM;
    for (;;) {
#pragma unroll
        for (int i = 0; i < 4; ++i) { const int c = tid + 512 * i, row = c >> 3, cc = c & 7;
            *(LAS u32x4*)(Kl + row * KP + 16 * cc) = f.k[i]; *(LAS u32x4*)(Vl + row * KP + 16 * cc) = f.v[i]; }
        bf16x8 qf[4];
#pragma unroll
        for (int s = 0; s < 4; ++s) qf[s] = f.qf[s];
        const unsigned ent = f.ent; const int qrow = f.qrow; const bool valid = f.valid;
        asm volatile("" : "+v"(qf[0]), "+v"(qf[1]), "+v"(qf[2]), "+v"(qf[3]));
        __syncthreads();
        const bool has_next = next(ui + 1, nxt);
        if (has_next) ba_issue<MODE>(f, nxt, tid, wave, r32, h);
        f32x16 o[2]; float l = 0.f;
#pragma unroll
        for (int i = 0; i < 16; ++i) { o[0][i] = 0.f; o[1][i] = 0.f; }
        const int ntile = (MODE == 2) ? wave + 1 : 8;
#pragma unroll 2
        for (int kt = 0; kt < ntile; ++kt) {
            f32x16 sacc = negm;
#pragma unroll
            for (int s = 0; s < 4; ++s) { const bf16x8 kf = *(const LAS bf16x8*)(Kl + (32 * kt + r32) * KP + 2 * (16 * s + 8 * h)); sacc = MFMA32(kf, qf[s], sacc); }
            float p[16];
#pragma unroll
            for (int i = 0; i < 16; ++i) { float e = __builtin_amdgcn_exp2f(sacc[i]); if (MODE == 2) { if (kt == wave && crow(i, h) > r32) e = 0.f; } p[i] = e; l += e; }
            pv_tile(p, Vl + 32 * kt * KP, o, lane);
        }
        l += __shfl_xor(l, 32);
        if (MODE == 1) {
            if (valid) { const int slot = (int)(ent & 3u); const size_t sb = ((size_t)qrow * 6 + cur.head) * 3 + slot;
#pragma unroll
                for (int dh = 0; dh < 2; ++dh)
#pragma unroll
                    for (int g = 0; g < 4; ++g) { u32x2 w; w.x = pk2(o[dh][4 * g], o[dh][4 * g + 1]); w.y = pk2(o[dh][4 * g + 2], o[dh][4 * g + 3]); *(u32x2*)(slotO + sb * 64 + 32 * dh + 8 * g + 4 * h) = w; }
                if (h == 0) slotL[sb] = l; }
        } else {
            if (MODE == 2) {
                for (int sl = 0; sl < cur.nvalid; ++sl) { const size_t sb = ((size_t)qrow * 6 + cur.head) * 3 + sl;
#pragma unroll
                    for (int dh = 0; dh < 2; ++dh)
#pragma unroll
                        for (int g = 0; g < 4; ++g) { const u32x2 w = *(const u32x2*)(slotO + sb * 64 + 32 * dh + 8 * g + 4 * h);
                            o[dh][4 * g] += bf_lo(w.x); o[dh][4 * g + 1] += bf_hi(w.x); o[dh][4 * g + 2] += bf_lo(w.y); o[dh][4 * g + 3] += bf_hi(w.y); }
                    l += slotL[sb]; }
            }
            const float il = __builtin_amdgcn_rcpf(l);
            if (do_store)
#pragma unroll
            for (int dh = 0; dh < 2; ++dh)
#pragma unroll
                for (int g = 0; g < 4; ++g) { u32x2 w; w.x = pk2(o[dh][4 * g] * il, o[dh][4 * g + 1] * il); w.y = pk2(o[dh][4 * g + 2] * il, o[dh][4 * g + 3] * il);
                    *(u32x2*)(cur.O + (size_t)qrow * cur.opitch + 32 * dh + 8 * g + 4 * h) = w; }
        }
        __syncthreads();
        if (!has_next) break;
        cur = nxt; ++ui;
    }
}

struct DilState { int r, g, sh, kb0, kstep, ntile, qpos, t0, lim, koff, vcol; int voff[4]; bf16x8 qf[4]; bf16x8 kfn[4]; u32x4 vn[4]; };
DI void dil_load(DilState& s, const bf16_t* Kh, const bf16_t* Vh, int T, int h) {
    const int kb_ = s.kb0 + s.kstep * T; int kp_ = kb_ + s.koff; kp_ = kp_ < 0 ? 0 : kp_;
#pragma unroll
    for (int q = 0; q < 4; ++q) s.kfn[q] = *(const bf16x8*)(Kh + (size_t)kp_ * 64 + 16 * q + 8 * h);
#pragma unroll
    for (int i = 0; i < 4; ++i) { int vp_ = kb_ + s.voff[i]; vp_ = vp_ < 0 ? 0 : vp_; s.vn[i] = *(const u32x4*)(Vh + (size_t)vp_ * 64 + s.vcol); }
}
DI void dil_setup(DilState& s, int pi, const bf16_t* Qh, const bf16_t* Kh, const bf16_t* Vh, int P0, int lane, int wave) {
    const int r32 = lane & 31, h = lane >> 5;
    s.r = pi == 0 ? 1 : (pi == 1 ? 4 : 16); s.g = pi == 2 ? 2 : 1; s.sh = s.g - 1;
    int qb;
    if (pi == 0) { qb = P0 + 32 * wave; s.kb0 = qb - 128; s.kstep = 32; s.ntile = 5; }
    else if (pi == 1) { qb = P0 + (wave >> 1) + 128 * (wave & 1); s.kb0 = qb - 512; s.kstep = 128; s.ntile = 5; }
    else { qb = P0 + 2 * wave; s.kb0 = qb - 2048; s.kstep = 256; s.ntile = 9; }
    s.qpos = qb + (r32 & (s.g - 1)) + s.r * (r32 >> s.sh);
#pragma unroll
    for (int q = 0; q < 4; ++q) s.qf[q] = *(const bf16x8*)(Qh + (size_t)s.qpos * 64 + 16 * q + 8 * h);
    const int maxoff = (s.g - 1) + s.r * (31 >> s.sh);
    int t0 = 0; while (t0 < s.ntile && s.kb0 + s.kstep * t0 + maxoff < 0) ++t0;
    s.t0 = t0;
    s.lim = min(128 * s.r, s.qpos);
    s.koff = (r32 & (s.g - 1)) + s.r * (r32 >> s.sh);
#pragma unroll
    for (int i = 0; i < 4; ++i) { const int row = (lane >> 3) + 8 * i; s.voff[i] = (row & (s.g - 1)) + s.r * (row >> s.sh); }
    s.vcol = 8 * (lane & 7);
    if (t0 < s.ntile) dil_load(s, Kh, Vh, t0, h);
}
DI void dil_run(DilState& s, const bf16_t* Kh, const bf16_t* Vh, LAS unsigned char* vst0, const float negM, f32x16 (&o)[2], float& l, int lane) {
    const int h = lane >> 5;
    int offi[16];
#pragma unroll
    for (int i = 0; i < 16; ++i) { const int row = crow(i, h); offi[i] = (row & (s.g - 1)) + s.r * (row >> s.sh); }
#pragma unroll
    for (int i = 0; i < 16; ++i) { o[0][i] = 0.f; o[1][i] = 0.f; }
    l = 0.f;
#pragma unroll 2
    for (int t = s.t0; t < s.ntile; ++t) {
        LAS unsigned char* vst = vst0 + (t & 1) * (32 * KP);
        bf16x8 kf[4]; u32x4 vv[4];
#pragma unroll
        for (int q = 0; q < 4; ++q) { kf[q] = s.kfn[q]; vv[q] = s.vn[q]; }
        asm volatile("" : "+v"(kf[0]), "+v"(kf[1]), "+v"(kf[2]), "+v"(kf[3]));
        asm volatile("" : "+v"(vv[0]), "+v"(vv[1]), "+v"(vv[2]), "+v"(vv[3]));
        if (t + 1 < s.ntile) dil_load(s, Kh, Vh, t + 1, h);
#pragma unroll
        for (int i = 0; i < 4; ++i) *(LAS u32x4*)(vst + ((lane >> 3) + 8 * i) * KP + 2 * s.vcol) = vv[i];
        f32x16 sacc;
#pragma unroll
        for (int i = 0; i < 16; ++i) sacc[i] = 0.f;
#pragma unroll
        for (int q = 0; q < 4; ++q) sacc = MFMA32(kf[q], s.qf[q], sacc);
        const int dq = s.qpos - (s.kb0 + s.kstep * t);
        float p[16];
#pragma unroll
        for (int i = 0; i < 16; ++i) { const int d = dq - offi[i];
            const bool ok = ((unsigned)d <= (unsigned)s.lim) && ((d & (s.r - 1)) == 0);
            const float e = ok ? __builtin_amdgcn_exp2f(sacc[i] + negM) : 0.f; p[i] = e; l += e; }
        pv_tile(p, vst, o, lane);
    }
    l += __shfl_xor(l, 32);
}
DI void dil_accum(LAS float* accl, bool first, int ql, const f32x16 (&o)[2], float l, int h) {
    if (first) {
#pragma unroll
        for (int dh = 0; dh < 2; ++dh)
#pragma unroll
            for (int i = 0; i < 16; ++i) accl[ql * 65 + 32 * dh + crow(i, h)] = o[dh][i];
        if (h == 0) accl[ql * 65 + 64] = l;
    } else {
#pragma unroll
        for (int dh = 0; dh < 2; ++dh)
#pragma unroll
            for (int i = 0; i < 16; ++i) accl[ql * 65 + 32 * dh + crow(i, h)] += o[dh][i];
        if (h == 0) accl[ql * 65 + 64] += l;
    }
}
DI void dilated_unit(LAS unsigned char* lds, const bf16_t* proj, bf16_t* aout, int hd, int P0, float negM, bool do_store = true) {
    int tid_ = threadIdx.x; asm volatile("" : "+v"(tid_));
    const int tid = tid_, lane = tid & 63, wave = __builtin_amdgcn_readfirstlane(tid >> 6), h = lane >> 5;
    LAS float* accl = (LAS float*)lds;
    LAS unsigned char* vst0 = lds + 256 * 65 * 4 + wave * (2 * 32 * KP);
    const bf16_t* Qh = proj + OFF_QD + (size_t)hd * HS; const bf16_t* Kh = proj + OFF_KD + (size_t)hd * HS; const bf16_t* Vh = proj + OFF_VD + (size_t)hd * HS;
    DilState A, B; f32x16 o[2]; float l;
    dil_setup(A, 0, Qh, Kh, Vh, P0, lane, wave);
    dil_run(A, Kh, Vh, vst0, negM, o, l, lane);
    dil_setup(B, 1, Qh, Kh, Vh, P0, lane, wave);
    dil_accum(accl, true, A.qpos - P0, o, l, h);
    __syncthreads();
    dil_run(B, Kh, Vh, vst0, negM, o, l, lane);
    dil_setup(A, 2, Qh, Kh, Vh, P0, lane, wave);
    dil_accum(accl, false, B.qpos - P0, o, l, h);
    __syncthreads();
    dil_run(A, Kh, Vh, vst0, negM, o, l, lane);
    dil_accum(accl, false, A.qpos - P0, o, l, h);
    __syncthreads();
    if (do_store) { const int ql = tid >> 1, half = tid & 1; const float il = 1.f / accl[ql * 65 + 64];
        bf16_t* op = aout + (size_t)(P0 + ql) * DM + 384 + hd * 64 + 32 * half;
#pragma unroll
        for (int c = 0; c < 4; ++c) { float v[8];
#pragma unroll
            for (int e = 0; e < 8; ++e) v[e] = accl[ql * 65 + 32 * half + 8 * c + e] * il;
            u32x4 w; w.x = pk2(v[0], v[1]); w.y = pk2(v[2], v[3]); w.z = pk2(v[4], v[5]); w.w = pk2(v[6], v[7]); *(u32x4*)(op + 8 * c) = w; } }
    __syncthreads();
}

DI void top3_insert(float v, int idx, float& b0, float& b1, float& b2, int& i0, int& i1, int& i2) {
    const bool c0 = (v > b0) || (v == b0 && idx < i0), c1 = (v > b1) || (v == b1 && idx < i1), c2 = (v > b2) || (v == b2 && idx < i2);
    const float nb2 = c1 ? b1 : (c2 ? v : b2); const int ni2 = c1 ? i1 : (c2 ? idx : i2);
    const float nb1 = c0 ? b0 : (c1 ? v : b1); const int ni1 = c0 ? i0 : (c1 ? idx : i1);
    const float nb0 = c0 ? v : b0; const int ni0 = c0 ? idx : i0;
    b0 = nb0; b1 = nb1; b2 = nb2; i0 = ni0; i1 = ni1; i2 = ni2;
}
DI void select_unit(LAS unsigned char* lds, const bf16_t* proj, const float* kmean, unsigned* cnt, unsigned* lists, int hd, int n, bool do_store = true) {
    int tid_ = threadIdx.x; asm volatile("" : "+v"(tid_));
    const int tid = tid_, lane = tid & 63, wave = __builtin_amdgcn_readfirstlane(tid >> 6), r32 = lane & 31, h = lane >> 5;
    LAS unsigned char* Khi = lds; LAS unsigned char* Klo = lds + 64 * KP;
    LAS unsigned* hist = (LAS unsigned*)(lds + 32768);
    { const int row = tid >> 3, c8 = tid & 7; const float* kp = kmean + ((size_t)hd * 64 + row) * 64 + 8 * c8;
      const f32x4 x0 = *(const f32x4*)kp, x1 = *(const f32x4*)(kp + 4);
      u32x4 hv, lv;
      hv.x = pk2(x0[0], x0[1]); lv.x = pk2(x0[0] - bf_lo(hv.x), x0[1] - bf_hi(hv.x));
      hv.y = pk2(x0[2], x0[3]); lv.y = pk2(x0[2] - bf_lo(hv.y), x0[3] - bf_hi(hv.y));
      hv.z = pk2(x1[0], x1[1]); lv.z = pk2(x1[0] - bf_lo(hv.z), x1[1] - bf_hi(hv.z));
      hv.w = pk2(x1[2], x1[3]); lv.w = pk2(x1[2] - bf_lo(hv.w), x1[3] - bf_hi(hv.w));
      *(LAS u32x4*)(Khi + row * KP + 16 * c8) = hv;
      *(LAS u32x4*)(Klo + row * KP + 16 * c8) = lv; }
    if (tid < 128) hist[tid] = 0u;
    const int q = 256 * n + 32 * wave + r32;
    bf16x8 qf[4];
#pragma unroll
    for (int s = 0; s < 4; ++s) qf[s] = *(const bf16x8*)(proj + OFF_QA + (size_t)hd * HS + (size_t)q * 64 + 16 * s + 8 * h);
    __syncthreads();
    f32x16 g0, g1;
#pragma unroll
    for (int i = 0; i < 16; ++i) { g0[i] = 0.f; g1[i] = 0.f; }
#pragma unroll
    for (int s = 0; s < 4; ++s) { const int co = 2 * (16 * s + 8 * h);
        const bf16x8 a0 = *(const LAS bf16x8*)(Khi + r32 * KP + co), a1 = *(const LAS bf16x8*)(Klo + r32 * KP + co);
        const bf16x8 c0 = *(const LAS bf16x8*)(Khi + (32 + r32) * KP + co), c1 = *(const LAS bf16x8*)(Klo + (32 + r32) * KP + co);
        g0 = MFMA32(a0, qf[s], g0); g0 = MFMA32(a1, qf[s], g0); g1 = MFMA32(c0, qf[s], g1); g1 = MFMA32(c1, qf[s], g1); }
    float b0 = -INFINITY, b1 = -INFINITY, b2 = -INFINITY; int i0 = -1, i1 = -1, i2 = -1;
#pragma unroll
    for (int i = 0; i < 16; ++i) { const int blk = crow(i, h); const bool okb = blk < n; top3_insert(okb ? g0[i] : -INFINITY, okb ? blk : 1000, b0, b1, b2, i0, i1, i2); }
#pragma unroll
    for (int i = 0; i < 16; ++i) { const int blk = 32 + crow(i, h); const bool okb = blk < n; top3_insert(okb ? g1[i] : -INFINITY, okb ? blk : 1000, b0, b1, b2, i0, i1, i2); }
    {
        const float ob0 = __shfl_xor(b0, 32), ob1 = __shfl_xor(b1, 32), ob2 = __shfl_xor(b2, 32); const int oi0 = __shfl_xor(i0, 32), oi1 = __shfl_xor(i1, 32), oi2 = __shfl_xor(i2, 32);
        top3_insert(oi0 >= 0 ? ob0 : -INFINITY, oi0 >= 0 ? oi0 : 1000, b0, b1, b2, i0, i1, i2);
        top3_insert(oi1 >= 0 ? ob1 : -INFINITY, oi1 >= 0 ? oi1 : 1000, b0, b1, b2, i0, i1, i2);
        top3_insert(oi2 >= 0 ? ob2 : -INFINITY, oi2 >= 0 ? oi2 : 1000, b0, b1, b2, i0, i1, i2);
    }
    unsigned lr0 = 0u, lr1 = 0u, lr2 = 0u;
    if (h == 0) {
        if (i0 >= 0) lr0 = __hip_atomic_fetch_add(hist + i0, 1u, __ATOMIC_RELAXED, __HIP_MEMORY_SCOPE_WORKGROUP);
        if (i1 >= 0) lr1 = __hip_atomic_fetch_add(hist + i1, 1u, __ATOMIC_RELAXED, __HIP_MEMORY_SCOPE_WORKGROUP);
        if (i2 >= 0) lr2 = __hip_atomic_fetch_add(hist + i2, 1u, __ATOMIC_RELAXED, __HIP_MEMORY_SCOPE_WORKGROUP);
    }
    __syncthreads();
    if (tid < n) { const unsigned c = hist[tid]; hist[64 + tid] = (c && do_store) ? atomicAdd(cnt + hd * 64 + tid, c) : 0u; }
    __syncthreads();
    if (h == 0 && do_store) {
        unsigned* lh = lists + (size_t)hd * LIST_PER_HEAD;
        if (i0 >= 0) lh[list_off(i0) + hist[64 + i0] + lr0] = ((unsigned)q << 2) | 0u;
        if (i1 >= 0) lh[list_off(i1) + hist[64 + i1] + lr1] = ((unsigned)q << 2) | 1u;
        if (i2 >= 0) lh[list_off(i2) + hist[64 + i2] + lr2] = ((unsigned)q << 2) | 2u;
    }
    __syncthreads();
}

struct OneBA { BAUnit u0; DI bool operator()(int i, BAUnit& u) const { if (i) return false; u = u0; return true; } };
struct MemNext { bf16_t* mkv_; bf16_t* proj_; bf16_t* ao_; int e0, stride, n;
    DI bool operator()(int i, BAUnit& u) const { const int e = e0 + stride * i; if (e >= n) return false; const int hm = e >> 6, qt = e & 63;
        u.Kg = mkv_ + hm * 64; u.Vg = mkv_ + 256 + hm * 64; u.kpitch = 512; u.Q = proj_ + OFF_QM + (size_t)hm * HS; u.qpitch = 64; u.q0 = qt * 256; u.list = nullptr; u.count = 0; u.head = 0; u.nvalid = 0; u.O = ao_ + 768 + hm * 64; u.opitch = DM; return true; } };
struct GathNext { LAS int* pre; int T, bx, G; const unsigned* cnt_; bf16_t* proj_; const unsigned* lists_;
    DI bool operator()(int i, BAUnit& u) const { const int ui = bx + i * G; if (ui >= T) return false;
        int e, t, c;
        if (i < 16) { e = pre[512 + 3 * i]; t = pre[513 + 3 * i]; c = pre[514 + 3 * i]; }
        else { int lo = 0, hi = 377; while (lo < hi) { const int mid = (lo + hi) >> 1; if (pre[mid] > ui) hi = mid; else lo = mid + 1; }
               e = lo; t = ui - (e ? pre[e - 1] : 0); c = (int)cnt_[(e / 63) * 64 + e % 63]; }
        const int hd = e / 63, n = e % 63;
        u.Kg = proj_ + OFF_KA + (size_t)hd * HS + (size_t)(256 * n) * 64; u.Vg = proj_ + OFF_VA + (size_t)hd * HS + (size_t)(256 * n) * 64; u.kpitch = 64; u.Q = proj_ + OFF_QA + (size_t)hd * HS; u.qpitch = 64; u.q0 = 0; u.O = nullptr; u.opitch = 0;
        u.list = lists_ + (size_t)hd * LIST_PER_HEAD + list_off(n) + 256 * t; u.count = c - 256 * t; u.head = hd; u.nvalid = 0; return true; } };
struct OwnNext { int bx, G; bf16_t* proj_; bf16_t* ao_;
    DI bool operator()(int i, BAUnit& u) const { const int ui = bx + i * G; if (ui >= 6 * 64) return false; const int hd = ui >> 6, n = 63 - (ui & 63);
        u.Kg = proj_ + OFF_KA + (size_t)hd * HS + (size_t)(256 * n) * 64; u.Vg = proj_ + OFF_VA + (size_t)hd * HS + (size_t)(256 * n) * 64; u.kpitch = 64; u.Q = proj_ + OFF_QA + (size_t)hd * HS; u.qpitch = 64; u.q0 = 256 * n; u.O = ao_ + hd * 64; u.opitch = DM;
        u.list = nullptr; u.count = 0; u.head = hd; u.nvalid = n < 3 ? n : 3; return true; } };

#define XB_TMO      128
#define XB_XCNT(j)  (256  + 64 * (j))
#define XB_XSUB(j)  (1280 + 64 * (j))
#define XB_XGEN(j)  (2304 + 64 * (j))
#define XB_TOP      3328
#define XB_TOPGEN   3392
#define XCD_BAR_WORDS 3456
#define XB_SPIN_CAP (1u << 18)
DI unsigned xb_ld(unsigned* p)              { return __hip_atomic_load(p, __ATOMIC_RELAXED, __HIP_MEMORY_SCOPE_AGENT); }
DI unsigned xb_add(unsigned* p, unsigned v) { return __hip_atomic_fetch_add(p, v, __ATOMIC_RELAXED, __HIP_MEMORY_SCOPE_AGENT); }
DI unsigned xb_xcc_id() { return (unsigned)__builtin_amdgcn_s_getreg((3 << 11) | 20) & 0xFu; }
#define XB_SPIN(cond, bar) do { unsigned _sp = 0; while (cond) { __builtin_amdgcn_s_sleep(1); \
    if ((++_sp & 255u) == 0u) { if (xb_ld(&(bar)[XB_TMO])) break; if (_sp > XB_SPIN_CAP) { atomicAdd(&(bar)[XB_TMO], 1u); break; } } } } while (0)
struct XcdBarrier { unsigned* bar; unsigned x; volatile LAS unsigned* st; };
DI XcdBarrier xcd_barrier_post(unsigned* bar, volatile LAS unsigned* st) {
    XcdBarrier b; b.bar = bar; b.x = xb_xcc_id(); b.st = st;
    if (threadIdx.x == 0) (void)xb_add(&bar[XB_XCNT(b.x)], 1u);
    return b;
}
DI void xcd_barrier_complete(unsigned* bar, unsigned x, unsigned& nloc, unsigned& nx) {
    const unsigned G = gridDim.x * gridDim.y * gridDim.z;
    unsigned sum, cnt_, mine, sp = 0u;
    for (;;) {
        sum = 0u; cnt_ = 0u; mine = 0u;
#pragma unroll
        for (unsigned j = 0; j < 16; ++j) { const unsigned c = xb_ld(&bar[XB_XCNT(j)]); sum += c; cnt_ += (c > 0u) ? 1u : 0u; mine = (j == x) ? c : mine; }
        if (sum == G) break;
        __builtin_amdgcn_s_sleep(1);
        if ((++sp & 255u) == 0u) { if (xb_ld(&bar[XB_TMO])) break; if (sp > XB_SPIN_CAP) { atomicAdd(&bar[XB_TMO], 1u); break; } }
    }
    nloc = mine > 0u ? mine : 1u; nx = cnt_ > 0u ? cnt_ : 1u;
}
DI void xcd_barrier(const XcdBarrier& b) {
    asm volatile("s_waitcnt vmcnt(0)" ::: "memory");
    __syncthreads();
    if (threadIdx.x == 0) {
        unsigned* bar = b.bar;
        __builtin_amdgcn_s_waitcnt(0);
        unsigned nloc = b.st[0], nx = b.st[1];
        if (nloc == 0u) { xcd_barrier_complete(bar, b.x, nloc, nx); b.st[0] = nloc; b.st[1] = nx; }
        const unsigned old = xb_add(&bar[XB_XSUB(b.x)], 1u);
        const unsigned gen = old / nloc;
        if (old + 1u == (gen + 1u) * nloc) {
            __builtin_amdgcn_fence(__ATOMIC_RELEASE, "agent");
            asm volatile("s_waitcnt vmcnt(0)" ::: "memory");
            const unsigned og = xb_add(&bar[XB_TOP], 1u);
            const unsigned tg = og / nx;
            if (og + 1u == (tg + 1u) * nx) xb_add(&bar[XB_TOPGEN], 1u);
            else XB_SPIN(xb_ld(&bar[XB_TOPGEN]) == tg, bar);
            __builtin_amdgcn_fence(__ATOMIC_ACQUIRE, "agent");
            xb_add(&bar[XB_XGEN(b.x)], 1u);
            asm volatile("s_waitcnt vmcnt(0)" ::: "memory");
        } else {
            XB_SPIN(xb_ld(&bar[XB_XGEN(b.x)]) == gen, bar);
            __builtin_amdgcn_fence(__ATOMIC_ACQUIRE, "agent");
            asm volatile("s_waitcnt vmcnt(0)" ::: "memory");
        }
    }
    __syncthreads();
}

DI int ltid() { int t = threadIdx.x; asm volatile("" : "+v"(t)); return t; }
typedef const __attribute__((address_space(4))) Params* KParams;
DI KParams kpar() { KParams q = (KParams)__builtin_amdgcn_kernarg_segment_ptr(); asm volatile("" : "+s"(q)); return q; }
DI unsigned char* wsb_() { unsigned char* w = kpar()->ws; asm volatile("" : "+s"(w)); return w; }
DI unsigned char* outb_() { unsigned char* w = (unsigned char*)kpar()->out; asm volatile("" : "+s"(w)); return w; }
#define wsb(p_) wsb_()
#define outb(p_) outb_()
#define XBAR_NOW (XcdBarrier{(unsigned*)(wsb_() + WS_CTL + CTL_BAR), xb_xcc_id(), (volatile LAS unsigned*)(lds + LDS_BYTES - 64)})
#define p (*kpar())
__global__ void __launch_bounds__(512, 2) fwd_megakernel(Params p_arg) {
    extern __shared__ __attribute__((aligned(16))) unsigned char lds_raw[];
    LAS unsigned char* lds = (LAS unsigned char*)lds_raw;
    cg::grid_group grid = cg::this_grid();
    const int G = gridDim.x, bx = blockIdx.x;
    { const int tid = threadIdx.x;
    if (tid < 4) ((volatile LAS unsigned*)(lds + LDS_BYTES - 64))[tid] = 0u;
    __syncthreads();
    }
    (void)xcd_barrier_post((unsigned*)(p.ws + WS_CTL + CTL_BAR), (volatile LAS unsigned*)(lds + LDS_BYTES - 64));
    unsigned char* ws = p.ws;
#define cnt ((unsigned*)(wsb(p) + WS_CTL + CTL_CNT))
#define kmean ((float*)(wsb(p) + WS_CTL + CTL_KMEAN))
#define rstd1 ((float*)(wsb(p) + WS_RSTD1))
#define ssq2 ((float*)(wsb(p) + WS_SSQ2))
#define cosT ((float*)(wsb(p) + WS_COS))
#define sinT ((float*)(wsb(p) + WS_SIN))
#define memn ((bf16_t*)(wsb(p) + WS_MEMN))
#define mkv ((bf16_t*)(wsb(p) + WS_MKV))
#define w_in_t ((bf16_t*)(wsb(p) + WS_WIN))
#define w_up_t ((bf16_t*)(wsb(p) + WS_WUP))
#define w_down_t ((bf16_t*)(wsb(p) + WS_WDOWN))
#define w_out_t ((bf16_t*)(wsb(p) + WS_WOUT))
#define w_ba_t ((bf16_t*)(wsb(p) + WS_WBA))
#define w_bd_t ((bf16_t*)(wsb(p) + WS_WBD))
#define w_bm_t ((bf16_t*)(wsb(p) + WS_WBM))
#define w_mkv_t ((bf16_t*)(wsb(p) + WS_WMKV))
#define xb ((bf16_t*)(wsb(p) + WS_XB))
#define merged ((bf16_t*)(wsb(p) + WS_PROJ))
#define attn_out ((bf16_t*)(wsb(p) + WS_XB))
#define proj ((bf16_t*)(wsb(p) + WS_PROJ))
#define x1b ((bf16_t*)(wsb(p) + WS_XB))
#define gates ((bf16_t*)(wsb(p) + WS_GATES))
#define act ((bf16_t*)(wsb(p) + WS_GATES))
#define slotO ((bf16_t*)(outb(p) + DO_SLOTO))
#define slotL ((float*)(outb(p) + DO_SLOTL))
#define lists ((unsigned*)(outb(p) + DO_LIST))

    for (int rep_ = 0; rep_ < REP_P0; ++rep_) {
    {
        const int tid = ltid(), lane = tid & 63, wave = __builtin_amdgcn_readfirstlane(tid >> 6); (void)lane; (void)wave;
        LAS float* scr = (LAS float*)(lds + wave * 16384);
        const int gw = bx * 8 + wave, NGW = G * 8;
        constexpr int I_IN = 16 * 176, I_MKV = 16 * 16;
        for (int it = gw; it < I_IN + I_MKV; it += NGW) {
            if (it < I_IN) p0_transpose_item(p.w_in, DM, INC, p.mix_g, w_in_t, 0, scr, it, lane);
            else p0_transpose_item(p.w_memkv, DM, 512, nullptr, w_mkv_t, 0, scr, it - I_IN, lane);
        }
        for (int m0 = 2 * gw; m0 < S + NMEM; m0 += 2 * NGW) {
            f32x4 v[2][4]; float s[2];
#pragma unroll
            for (int q = 0; q < 2; ++q) { const int m = m0 + q; const float* src_ = (m >= S) ? p.mem + (size_t)(m - S) * DM : p.x + (size_t)m * DM;
                const f32x4* xr = (const f32x4*)src_ + lane;
#pragma unroll
                for (int j = 0; j < 4; ++j) v[q][j] = xr[64 * j]; }
#pragma unroll
            for (int q = 0; q < 2; ++q) { float t = 0.f;
#pragma unroll
                for (int j = 0; j < 4; ++j) t += (v[q][j][0] * v[q][j][0] + v[q][j][1] * v[q][j][1]) + (v[q][j][2] * v[q][j][2] + v[q][j][3] * v[q][j][3]);
                s[q] = t; }
#pragma unroll
            for (int q = 0; q < 2; ++q) { const int m = m0 + q; const bool ismem = m >= S;
                const float rstd = rsqrtf(wave_sum(s[q]) * (1.f / DM) + EPS);
                bf16_t* dst = ismem ? memn + (size_t)(m - S) * DM : xb + (size_t)m * DM;
                if (ismem) {
#pragma unroll
                    for (int j = 0; j < 4; ++j) { const f32x4 gg = *((const f32x4*)p.memn_g + lane + 64 * j); v[q][j] = v[q][j] * rstd * gg; }
                } else if (lane == 0) rstd1[m] = rstd;
#pragma unroll
                for (int j = 0; j < 4; ++j) { u32x2 w; w.x = pk2(v[q][j][0], v[q][j][1]); w.y = pk2(v[q][j][2], v[q][j][3]); *((u32x2*)dst + lane + 64 * j) = w; } }
        }
        { const float inv_freq = powf(10000.f, -(float)(tid & 31) / 32.f);
          for (int i = bx * 512 + tid; i < S * 32; i += G * 512) { const int t = i >> 5;
            const float ang = (float)p.pos[t] * inv_freq; float sn, cs; sincosf(ang, &sn, &cs);
            cosT[i] = cs; sinT[i] = sn; } }
        for (int i = bx * 512 + tid; i < (int)((CTL_KMEAN + 6 * 64 * 64 * 4) / 4); i += G * 512) ((unsigned*)(wsb_() + WS_CTL))[i] = 0u;
    }
    if (gridDim.y > 1) grid.sync();
    xcd_barrier(XBAR_NOW);

    }
    for (int rep_ = 0; rep_ < REP_P1; ++rep_) {
    {
        const int tid = ltid(), lane = tid & 63, wave = __builtin_amdgcn_readfirstlane(tid >> 6); (void)lane; (void)wave;
        pg8::Gemm g{xb, w_in_t, S, INC, DM, DM, 0}; pg8::StaticOrder So; So.init(S, INC, G, bx);
        EpiIn E{0, proj, QKVW, gates, rstd1, cosT, sinT, p.aq_g, p.ak_g, p.dq_g, p.dk_g, p.eq_g, (rep_ == REP_P1 - 1) ? kmean : nullptr};
        pg8::gemm_phase<EpiIn, pg8::StaticOrder>(lds, g, So, E);
        pg8::Gemm g2{memn, w_mkv_t, NMEM, 512, DM, DM, 0}; pg8::OneUnit O1; O1.have = (bx >= G - 2) ? 1 : 0; O1.u0.pm = 0; O1.u0.pn = bx - (G - 2);
        EpiIn E2{1, mkv, 512, nullptr, nullptr, nullptr, nullptr, p.ek_g, nullptr, nullptr, nullptr, nullptr, nullptr};
        pg8::gemm_phase<EpiIn, pg8::OneUnit>(lds, g2, O1, E2);
    }
    xcd_barrier(XBAR_NOW);

    }
    for (int rep_ = 0; rep_ < REP_P2; ++rep_) {
    {
        const int tid = ltid(), lane = tid & 63, wave = __builtin_amdgcn_readfirstlane(tid >> 6); (void)lane; (void)wave;
        const float negD = -softmax_bound(p.dq_g, p.dk_g, lane), negE = -softmax_bound(p.eq_g, p.ek_g, lane);
        constexpr int NU_D = 6 * 64, NU_E = 4 * 64, NU_S = 6 * 63;
        const bool last_rep = (rep_ == REP_P2 - 1);
        if (G == 256) {
            const int xc = bx & 7, xi = bx >> 3, vb = xc * 32 + xi, li = xc * 16 + (xi >> 1);
            dilated_unit(lds, proj, attn_out, vb >> 6, (vb & 63) * 256, negD, last_rep);
            if (!(xi & 1)) { const int ui = 256 + li; dilated_unit(lds, proj, attn_out, ui >> 6, (ui & 63) * 256, negD, last_rep); }
            else {
                { MemNext mn{mkv, proj, attn_out, li, 128, NU_E}; block_attn_loop<0>(lds, mn, negE, nullptr, nullptr, last_rep); }
                for (int e = li; e < NU_S; e += 128) { const int hd = e / 63, n = 1 + e % 63; select_unit(lds, proj, kmean, cnt, lists, hd, n, last_rep); }
            }
        } else
        for (int ui = bx; ui < NU_D + NU_E + NU_S; ui += G) {
            if (ui < NU_D) { dilated_unit(lds, proj, attn_out, ui >> 6, (ui & 63) * 256, negD, last_rep); }
            else if (ui < NU_D + NU_E) { MemNext mn{mkv, proj, attn_out, ui - NU_D, 1 << 20, NU_E}; block_attn_loop<0>(lds, mn, negE, nullptr, nullptr, last_rep); }
            else { const int e = ui - NU_D - NU_E, hd = e / 63, n = 1 + e % 63; select_unit(lds, proj, kmean, cnt, lists, hd, n, last_rep); }
        }
    }
    xcd_barrier(XBAR_NOW);
    }
    for (int rep_ = 0; rep_ < REP_P3; ++rep_) {
    {
        const int tid = ltid(), lane = tid & 63, wave = __builtin_amdgcn_readfirstlane(tid >> 6); (void)lane; (void)wave;
        const float negA = -softmax_bound(p.aq_g, p.ak_g, lane);
        LAS int* pre = (LAS int*)(lds + 81920);
        { int v = 0; if (tid < 378) { const int hd = tid / 63, n = tid % 63; v = ((int)cnt[hd * 64 + n] + 255) >> 8; }
          pre[tid] = v; __syncthreads();
          for (int off = 1; off < 512; off <<= 1) { const int a = (tid >= off) ? pre[tid - off] : 0; __syncthreads(); pre[tid] += a; __syncthreads(); } }
        const int T = pre[377];
        const int vb = (G == 256) ? (bx & 7) * 32 + (bx >> 3) : bx;
        if (tid < 16) { const int ui = vb + tid * G;
            if (ui < T) { int lo = 0, hi = 377; while (lo < hi) { const int mid = (lo + hi) >> 1; if (pre[mid] > ui) hi = mid; else lo = mid + 1; }
                pre[512 + 3 * tid] = lo; pre[513 + 3 * tid] = ui - (lo ? pre[lo - 1] : 0); pre[514 + 3 * tid] = (int)cnt[(lo / 63) * 64 + lo % 63]; } }
        __syncthreads();
        { GathNext gn{pre, T, vb, G, cnt, proj, lists}; block_attn_loop<1>(lds, gn, negA, slotO, slotL, true); }
    }
    xcd_barrier(XBAR_NOW);

    }
    for (int rep_ = 0; rep_ < REP_P3B; ++rep_) {
    {
        const int tid = ltid(), lane = tid & 63, wave = __builtin_amdgcn_readfirstlane(tid >> 6); (void)lane; (void)wave;
        const float negA = -softmax_bound(p.aq_g, p.ak_g, lane);
        {
            constexpr int I_UP = 16 * 176, I_DN = 44 * 32, I_OUT = 16 * 32, I_BA = 6 * 32, I_BD = 6 * 32, I_BM = 4 * 32, NIT2 = I_UP + I_DN + I_OUT + I_BA + I_BD + I_BM;
            LAS float* scr = (LAS float*)(lds + wave * 16384);
            const int nw = (G > 128) ? (G - 128) * 8 : G * 8, w0 = (G > 128) ? (bx - 128) * 8 + wave : bx * 8 + wave;
            if (G <= 128 || bx >= 128)
            for (int it = w0; it < NIT2; it += nw) {
                int r = it;
                if (r < I_UP) { p0_transpose_item(p.w_up, DM, INC, p.ffn_g, w_up_t, 1, scr, r, lane); continue; } r -= I_UP;
                if (r < I_DN) { p0_transpose_item(p.w_down, FF, DM, nullptr, w_down_t, 0, scr, r, lane); continue; } r -= I_DN;
                if (r < I_OUT) { p0_transpose_item(p.w_out, DM, DM, nullptr, w_out_t, 0, scr, r, lane); continue; } r -= I_OUT;
                if (r < I_BA) { p0_transpose_item(p.w_ba, 384, DM, nullptr, w_ba_t, 0, scr, r, lane); continue; } r -= I_BA;
                if (r < I_BD) { p0_transpose_item(p.w_bd, 384, DM, nullptr, w_bd_t, 0, scr, r, lane); continue; } r -= I_BD;
                p0_transpose_item(p.w_bm, 256, DM, nullptr, w_bm_t, 0, scr, r, lane, 384);
            }
            if (G <= 128 || bx >= 128) for (int i = w0 * 64 + lane; i < 1024 * 16; i += nw * 64) { const int rw = i >> 4, cc = i & 15; *(u32x4*)(w_bm_t + (size_t)rw * 384 + 256 + 8 * cc) = (u32x4){0u, 0u, 0u, 0u}; }
            __syncthreads();
        }
        { OwnNext on{bx, G, proj, attn_out}; block_attn_loop<2>(lds, on, negA, slotO, slotL, rep_ == REP_P3B - 1); }
    }
    xcd_barrier(XBAR_NOW);

    }
    for (int rep_ = 0; rep_ < REP_P4; ++rep_) {
    {
        const int tid = ltid(), lane = tid & 63, wave = __builtin_amdgcn_readfirstlane(tid >> 6); (void)lane; (void)wave;
        pg8::StaticOrder So; So.init(S, DM, G, bx);
        for (int i = 0; ; ++i) { pg8::Unit u; if (!So.next(i, u)) break;
            pg8::Chain3 g; g.A[0] = attn_out; g.A[1] = attn_out + 384; g.A[2] = attn_out + 768; g.B[0] = w_ba_t; g.B[1] = w_bd_t; g.B[2] = w_bm_t; g.K = 384; g.lda = DM; g.u = u;
            EpiGate3 E{merged, gates}; pg8::gemm_chain3<EpiGate3>(lds, g, E); }
    }
    xcd_barrier(XBAR_NOW);

    }
    for (int rep_ = 0; rep_ < REP_P5; ++rep_) {
    {
        const int tid = ltid(), lane = tid & 63, wave = __builtin_amdgcn_readfirstlane(tid >> 6); (void)lane; (void)wave;
        if (bx == 0) { for (int i = tid; i < 1024; i += 512) ((unsigned*)(ws + WS_XB - 4096))[i] = 0u; }
        pg8::Gemm g{merged, w_out_t, S, DM, DM, DM, 0}; pg8::StaticOrder So; So.init(S, DM, G, bx);
        EpiRes1 E{p.x, p.out, x1b, ssq2}; pg8::gemm_phase<EpiRes1, pg8::StaticOrder>(lds, g, So, E);
    }
    xcd_barrier(XBAR_NOW);

    }
    for (int rep_ = 0; rep_ < REP_P6; ++rep_) {
    {
        const int tid = ltid(), lane = tid & 63, wave = __builtin_amdgcn_readfirstlane(tid >> 6); (void)lane; (void)wave;
        pg8::Gemm g{x1b - 2 * DM, w_up_t, 67 * 256, INC, DM, DM, 1}; pg8::StaticOrder So; So.init(67 * 256, INC, G, bx);
        EpiConv E{act, ssq2, p.conv_w, p.conv_b}; pg8::gemm_phase<EpiConv, pg8::StaticOrder>(lds, g, So, E);
    }
    xcd_barrier(XBAR_NOW);

    }
    for (int rep_ = 0; rep_ < REP_P7; ++rep_) {
    {
        const int tid = ltid(), lane = tid & 63, wave = __builtin_amdgcn_readfirstlane(tid >> 6); (void)lane; (void)wave;
        pg8::Gemm g{act, w_down_t, S, DM, FF, FF, 0}; pg8::StaticOrder So; So.init(S, DM, G, bx);
        EpiRes2 E{p.out, x1b, rep_ == REP_P7 - 1 ? 1 : 0}; pg8::gemm_phase<EpiRes2, pg8::StaticOrder>(lds, g, So, E);
    }
    if (rep_ + 1 < REP_P7) xcd_barrier(XBAR_NOW);
    }
}

#undef p
extern "C" void kernel_launch(void* const* d_in, const int* in_sizes, int n_in, void* d_out, int out_size, void* d_ws, size_t ws_size, hipStream_t stream) {
    static int grid = 0;
    if (grid == 0) {
        if (n_in != 22 || ws_size < WS_END) { fprintf(stderr, "kernel_launch: unexpected inputs (n_in %d, ws %zu)\n", n_in, ws_size); grid = -1; return; }
        int dev = 0, cus = 0, per_cu = 0;
        hipGetDevice(&dev); hipDeviceGetAttribute(&cus, hipDeviceAttributeMultiprocessorCount, dev);
        hipFuncSetAttribute((const void*)fwd_megakernel, hipFuncAttributeMaxDynamicSharedMemorySize, LDS_BYTES);
        hipOccupancyMaxActiveBlocksPerMultiprocessor(&per_cu, (const void*)fwd_megakernel, 512, LDS_BYTES);
        if (per_cu < 1) per_cu = 1;
        grid = cus * 1;
        (void)hipGetLastError();
    }
    if (grid < 0) return;
    hipMemsetAsync((char*)d_ws + WS_CTL + CTL_BAR, 0, 16384, stream);
    Params p{};
    p.x = (const float*)d_in[0]; p.mem = (const float*)d_in[1]; p.pos = (const int*)d_in[2];
    p.mix_g = (const float*)d_in[3]; p.memn_g = (const float*)d_in[4]; p.w_in = (const float*)d_in[5];
    p.aq_g = (const float*)d_in[6]; p.ak_g = (const float*)d_in[7]; p.dq_g = (const float*)d_in[8]; p.dk_g = (const float*)d_in[9];
    p.eq_g = (const float*)d_in[10]; p.ek_g = (const float*)d_in[11]; p.w_memkv = (const float*)d_in[12];
    p.w_ba = (const float*)d_in[13]; p.w_bd = (const float*)d_in[14]; p.w_bm = (const float*)d_in[15]; p.w_out = (const float*)d_in[16];
    p.ffn_g = (const float*)d_in[17]; p.w_up = (const float*)d_in[18]; p.conv_w = (const float*)d_in[19]; p.conv_b = (const float*)d_in[20]; p.w_down = (const float*)d_in[21];
    p.out = (float*)d_out; p.ws = (unsigned char*)d_ws;
    void* args[] = {&p};
    hipError_t e = hipLaunchCooperativeKernel((const void*)fwd_megakernel, dim3(grid), dim3(512), args, LDS_BYTES, stream);
    if (e != hipSuccess) fprintf(stderr, "cooperative launch failed: %s (grid %d)\n", hipGetErrorString(e), grid);
}
```

```cpp
#include <hip/hip_runtime.h>
#include <hip/hip_cooperative_groups.h>
#include <cstdio>
#include <cstdint>
namespace cg = cooperative_groups;

#define DI __device__ __forceinline__
#define LAS __attribute__((address_space(3)))
typedef unsigned short bf16_t;
typedef short bf16x8 __attribute__((ext_vector_type(8)));
typedef short s16x4 __attribute__((ext_vector_type(4)));
typedef float f32x4 __attribute__((ext_vector_type(4)));
typedef float f32x16 __attribute__((ext_vector_type(16)));
typedef unsigned u32x4 __attribute__((ext_vector_type(4)));
typedef unsigned u32x2 __attribute__((ext_vector_type(2)));
typedef float f32x2_t __attribute__((ext_vector_type(2)));
typedef __bf16 bf16x2_t __attribute__((ext_vector_type(2)));

DI int my_shfl_xor(int v, int k) { int l = (int)__lane_id(); asm volatile("" : "+v"(l)); return __builtin_amdgcn_ds_bpermute((l ^ k) << 2, v); }
DI float my_shfl_xor(float v, int k) { return __builtin_bit_cast(float, my_shfl_xor(__builtin_bit_cast(int, v), k)); }
#define __shfl_xor(v, k) my_shfl_xor((v), (k))
DI unsigned pk2(float lo, float hi) { f32x2_t v = {lo, hi}; bf16x2_t b = __builtin_convertvector(v, bf16x2_t); return __builtin_bit_cast(unsigned, b); }
DI float bf_lo(unsigned w) { return __uint_as_float(w << 16); }
DI float bf_hi(unsigned w) { return __uint_as_float(w & 0xffff0000u); }

constexpr int S = 16384, DM = 1024, INC = 5632, QKVW = 2560, GW = 3072, FF = 2816, NMEM = 256;
constexpr float EPS = 1e-6f;
constexpr float C2 = 0.125f * 1.4426950408889634f;
constexpr int C_QA = 0, C_KA = 384, C_VA = 768, C_QD = 1152, C_KD = 1536, C_VD = 1920, C_QM = 2304;
constexpr size_t HS = (size_t)S * 64;
constexpr size_t OFF_QA = 0, OFF_KA = 6 * HS, OFF_VA = 12 * HS, OFF_QD = 18 * HS, OFF_KD = 24 * HS, OFF_VD = 30 * HS, OFF_QM = 36 * HS;

constexpr size_t MiB = 1u << 20;
constexpr size_t WS_CTL = 0, CTL_ZERO_BYTES = 1 * MiB;
constexpr size_t CTL_CNT = 0;
constexpr size_t CTL_KMEAN = 4096;
constexpr size_t CTL_BAR = 512 * 1024;
constexpr size_t WS_RSTD1 = 1 * MiB;
constexpr size_t WS_SSQ2 = 1 * MiB + 128 * 1024;
constexpr size_t WS_COS = 3 * MiB, WS_SIN = 5 * MiB;
constexpr size_t WS_MEMN = 7 * MiB;
constexpr size_t WS_MKV = 7 * MiB + 512 * 1024;
constexpr size_t WS_WIN = 8 * MiB, WS_WUP = 19 * MiB, WS_WDOWN = 30 * MiB, WS_WOUT = 36 * MiB;
constexpr size_t WS_WBA = 38 * MiB, WS_WBD = 38 * MiB + 768 * 1024, WS_WBM = 41 * MiB, WS_WMKV = 40 * MiB;
constexpr size_t WS_XB = 42 * MiB;
constexpr size_t WS_PROJ = 76 * MiB;
constexpr size_t WS_GATES = 158 * MiB;
constexpr size_t WS_END = 254 * MiB;
constexpr size_t DO_SLOTO = 0;
constexpr size_t DO_SLOTL = 36 * MiB;
constexpr size_t DO_LIST = 38 * MiB;
constexpr int LIST_PER_HEAD = 516096;
DI int list_off(int n) { return n * S - 128 * n * (n + 1); }

constexpr int LDS_BYTES = 147456;
#ifndef REP_P0
#define REP_P0 1
#endif
#ifndef REP_P3
#define REP_P3 1
#endif
#ifndef REP_P4
#define REP_P4 1
#endif
#ifndef REP_P1
#define REP_P1 1
#endif
#ifndef REP_P2
#define REP_P2 1
#endif
#ifndef REP_P3B
#define REP_P3B 1
#endif
#ifndef REP_P7
#define REP_P7 1
#endif
#ifndef REP_P5
#define REP_P5 1
#endif
#ifndef REP_P6
#define REP_P6 1
#endif


namespace pg8 {
constexpr int BM = 256, BK = 64, HALF = 128, HTB = HALF * BK * 2, STAGE_BYTES = 8 * HTB, NXCD = 8, WGM = 8;
__host__ __device__ __forceinline__ int lds_byte(int r, int c) { const int st = (r >> 4) * 2 + (c >> 5), rr = r & 15, cc = c & 31, ob = rr * 64 + cc * 2; return st * 1024 + (ob ^ (((ob >> 9) & 1) << 5)); }
__host__ __device__ __forceinline__ void stage_rc(int b, int& R, int& C) { const int st = b / 1024, sb = b % 1024, swz = sb ^ (((sb >> 9) & 1) << 5); R = (st >> 1) * 16 + swz / 64; C = (st & 1) * 32 + (swz % 64) / 2; }
struct Unit { int pm, pn; };
struct Gemm { const bf16_t* A; const bf16_t* Bt; int M, N, K, lda, halo; };
struct StaticOrder {
    int nM, nN, nwg, G, c;
    DI void init(int M, int N, int G_, int c_) { nM = M / BM; nN = N / BM; nwg = nM * nN; G = G_; c = c_; }
    DI bool next(int i, Unit& u) const {
        const long L = (long)i * G + c; if (L >= nwg) return false;
        int wgid = (int)L; { const int q = nwg / NXCD, r = nwg % NXCD, xcd = wgid % NXCD, off = wgid / NXCD; wgid = (xcd < r ? xcd * (q + 1) : r * (q + 1) + (xcd - r) * q) + off; }
        const int nig = WGM * nN, gid = wgid / nig, fm = gid * WGM, gsz = (nM - fm) < WGM ? (nM - fm) : WGM;
        u.pm = fm + ((wgid % nig) % gsz); u.pn = (wgid % nig) / gsz; return true;
    }
};
struct OneUnit { int have; Unit u0; DI bool next(int i, Unit& u) const { if (i == 0 && have) { u = u0; return true; } return false; } };

template <class Epi, class Sched>
DI void gemm_phase(LAS unsigned char* lds, const Gemm g, const Sched& S, const Epi& E) {
    int tid_ = threadIdx.x; asm volatile("" : "+v"(tid_));
    const int tid = tid_, wid = __builtin_amdgcn_readfirstlane(tid >> 6), lane = tid & 63, wr = wid >> 2, wc = wid & 3, fr = lane & 15, fq = lane >> 4;
    const int K = g.K, nt = K / BK;
    unsigned voffA[2], voffB[2];
#pragma unroll
    for (int i = 0; i < 2; ++i) { int R, C; stage_rc(tid * 16 + i * 8192, R, C); const int Ra = g.halo ? (62 * (R >> 6) + 4 * (R & 15) + ((R >> 4) & 3)) : R;
        voffA[i] = (unsigned)(Ra * g.lda + C) * 2u; voffB[i] = (unsigned)(R * K + C) * 2u; }
    const size_t kstep = (size_t)(BK * 2);
    const size_t hstepA = (size_t)(g.halo ? 124 : 128) * g.lda * 2, tstepA = 2 * hstepA;
    const size_t hstepB = (size_t)HALF * K * 2, tstepB = 2 * hstepB;
    const unsigned ldsw = (unsigned)wid * 1024u;
    const int aoff = lds_byte(wr * 64 + fr, fq * 8), boff = lds_byte(wc * 32 + fr, fq * 8);
#define PG8_SA(b, h) (((b) * 2 + (h)) * HTB)
#define PG8_SB(b, h) ((4 + (b) * 2 + (h)) * HTB)
#define PG8_STAGE(bufoff, gbase, voff) do { _Pragma("unroll") for (int _i = 0; _i < 2; ++_i) \
        __builtin_amdgcn_global_load_lds((const unsigned*)((const char*)(gbase) + (voff)[_i]), (LAS unsigned*)(lds + (bufoff) + ldsw + _i * 8192), 16, 0, 0); } while (0)
#define PG8_LDA(dst, b, h) do { _Pragma("unroll") for (int m = 0; m < 4; ++m) _Pragma("unroll") for (int k = 0; k < 2; ++k) dst[m][k] = *(const LAS bf16x8*)(lds + PG8_SA(b, h) + aoff + m * 2048 + k * 1024); } while (0)
#define PG8_LDB(dst, b, h) do { _Pragma("unroll") for (int n = 0; n < 2; ++n) _Pragma("unroll") for (int k = 0; k < 2; ++k) dst[n][k] = *(const LAS bf16x8*)(lds + PG8_SB(b, h) + boff + n * 2048 + k * 1024); } while (0)
#define PG8_MMA(ai, bj, At, Bt) do { __builtin_amdgcn_s_setprio(1); _Pragma("unroll") for (int m = 0; m < 4; ++m) _Pragma("unroll") for (int n = 0; n < 2; ++n) _Pragma("unroll") for (int k = 0; k < 2; ++k) \
        acc[ai][bj][m][n] = __builtin_amdgcn_mfma_f32_16x16x32_bf16(Bt[n][k], At[m][k], acc[ai][bj][m][n], 0, 0, 0); __builtin_amdgcn_s_setprio(0); } while (0)
#define PG8_WAIT_V(n) asm volatile("s_waitcnt vmcnt(" #n ")" ::: "memory")
#define PG8_WAIT_L(n) asm volatile("s_waitcnt lgkmcnt(" #n ")" ::: "memory")
#define PG8_BAR __builtin_amdgcn_s_barrier()
#define PG8_SCHED __builtin_amdgcn_sched_barrier(0)
    Unit cur, nxt; int ui = 0;
    if (!S.next(0, cur)) return;
    f32x4 acc[2][2][4][2];
#pragma unroll
    for (int a = 0; a < 2; ++a)
#pragma unroll
        for (int b = 0; b < 2; ++b)
#pragma unroll
            for (int m = 0; m < 4; ++m)
#pragma unroll
                for (int n = 0; n < 2; ++n) acc[a][b][m][n] = (f32x4){0.f, 0.f, 0.f, 0.f};
    bf16x8 At[4][2], B0[2][2], B1[2][2];
    const char* cA = (const char*)g.A + (size_t)cur.pm * tstepA; const char* cB = (const char*)g.Bt + (size_t)cur.pn * tstepB;
    PG8_STAGE(PG8_SB(0, 0), cB, voffB); PG8_STAGE(PG8_SB(0, 1), cB + hstepB, voffB); PG8_STAGE(PG8_SA(0, 0), cA, voffA); PG8_STAGE(PG8_SA(0, 1), cA + hstepA, voffA);
    if (wr == 1) PG8_BAR;
    PG8_WAIT_V(2); PG8_BAR;
    PG8_STAGE(PG8_SB(1, 0), cB + kstep, voffB); PG8_STAGE(PG8_SA(1, 0), cA + kstep, voffA); PG8_STAGE(PG8_SB(1, 1), cB + hstepB + kstep, voffB);
    PG8_WAIT_V(6); PG8_BAR;
    for (;;) {
        const bool has_next = S.next(ui + 1, nxt);
        const char* nA = has_next ? (const char*)g.A + (size_t)nxt.pm * tstepA : cA; const char* nB = has_next ? (const char*)g.Bt + (size_t)nxt.pn * tstepB : cB;
        for (int t = 0; t < nt; t += 2) {
            const bool last = (t == nt - 2);
            const char* a1 = cA + (size_t)(t + 1) * kstep;
            const char* a2 = last ? nA : cA + (size_t)(t + 2) * kstep; const char* b2 = last ? nB : cB + (size_t)(t + 2) * kstep;
            const char* a3 = a2 + kstep; const char* b3 = b2 + kstep;
            PG8_LDB(B0, 0, 0); PG8_LDB(B1, 0, 1); PG8_SCHED; PG8_LDA(At, 0, 0); PG8_STAGE(PG8_SA(1, 1), a1 + hstepA, voffA);
            PG8_WAIT_V(8); PG8_WAIT_L(0); PG8_BAR; PG8_MMA(0, 0, At, B0); PG8_MMA(0, 1, At, B1); PG8_BAR; PG8_SCHED;
            PG8_LDA(At, 0, 1); PG8_STAGE(PG8_SB(0, 0), b2, voffB); PG8_STAGE(PG8_SB(0, 1), b2 + hstepB, voffB); PG8_STAGE(PG8_SA(0, 0), a2, voffA);
            PG8_WAIT_V(8); PG8_WAIT_L(0); PG8_BAR; PG8_MMA(1, 0, At, B0); PG8_MMA(1, 1, At, B1); PG8_BAR; PG8_SCHED;
            PG8_LDB(B0, 1, 0); PG8_LDB(B1, 1, 1); PG8_SCHED; PG8_LDA(At, 1, 0); PG8_STAGE(PG8_SA(0, 1), a2 + hstepA, voffA);
            PG8_WAIT_V(8); PG8_WAIT_L(0); PG8_BAR; PG8_MMA(0, 0, At, B0); PG8_MMA(0, 1, At, B1); PG8_BAR; PG8_SCHED;
            PG8_LDA(At, 1, 1); PG8_STAGE(PG8_SB(1, 0), b3, voffB); PG8_STAGE(PG8_SB(1, 1), b3 + hstepB, voffB); PG8_STAGE(PG8_SA(1, 0), a3, voffA);
            PG8_WAIT_V(8); PG8_WAIT_L(0); PG8_BAR; PG8_MMA(1, 0, At, B0); PG8_MMA(1, 1, At, B1); PG8_BAR; PG8_SCHED;
        }
        if (wr == 0) PG8_BAR;
        E(acc, cur, wr, wc, fr, fq);
        if (!has_next) break;
#pragma unroll
        for (int a = 0; a < 2; ++a)
#pragma unroll
            for (int b = 0; b < 2; ++b)
#pragma unroll
                for (int m = 0; m < 4; ++m)
#pragma unroll
                    for (int n = 0; n < 2; ++n) acc[a][b][m][n] = (f32x4){0.f, 0.f, 0.f, 0.f};
        cur = nxt; cA = nA; cB = nB; ++ui;
        if (wr == 1) PG8_BAR;
    }
    PG8_WAIT_V(0);
    PG8_BAR;
#undef PG8_SA
#undef PG8_SB
#undef PG8_STAGE
#undef PG8_LDA
#undef PG8_LDB
#undef PG8_MMA
#undef PG8_WAIT_V
#undef PG8_WAIT_L
#undef PG8_BAR
#undef PG8_SCHED
}
struct Chain3 { const bf16_t* A[3]; const bf16_t* B[3]; int K; int lda; Unit u; };
template <class EpiF>
DI void gemm_chain3(LAS unsigned char* lds, const Chain3 g, const EpiF& EF) {
    int tid_ = threadIdx.x; asm volatile("" : "+v"(tid_));
    const int tid = tid_, wid = __builtin_amdgcn_readfirstlane(tid >> 6), lane = tid & 63, wr = wid >> 2, wc = wid & 3, fr = lane & 15, fq = lane >> 4;
    unsigned voffA[2], voffB[2];
#pragma unroll
    for (int i = 0; i < 2; ++i) { int R, C; stage_rc(tid * 16 + i * 8192, R, C);
        voffA[i] = (unsigned)(R * g.lda + C) * 2u; voffB[i] = (unsigned)(R * g.K + C) * 2u; }
    const size_t kstep = (size_t)(BK * 2);
    const size_t hstepA = (size_t)128 * g.lda * 2, tstepA = 2 * hstepA;
    const size_t hstepB = (size_t)HALF * g.K * 2;
    const unsigned ldsw = (unsigned)wid * 1024u;
    const int aoff = lds_byte(wr * 64 + fr, fq * 8), boff = lds_byte(wc * 32 + fr, fq * 8);
#define PG8_SA(b, h) (((b) * 2 + (h)) * HTB)
#define PG8_SB(b, h) ((4 + (b) * 2 + (h)) * HTB)
#define PG8_STAGE(bufoff, gbase, voff) do { _Pragma("unroll") for (int _i = 0; _i < 2; ++_i) \
        __builtin_amdgcn_global_load_lds((const unsigned*)((const char*)(gbase) + (voff)[_i]), (LAS unsigned*)(lds + (bufoff) + ldsw + _i * 8192), 16, 0, 0); } while (0)
#define PG8_LDA(dst, b, h) do { _Pragma("unroll") for (int m = 0; m < 4; ++m) _Pragma("unroll") for (int k = 0; k < 2; ++k) dst[m][k] = *(const LAS bf16x8*)(lds + PG8_SA(b, h) + aoff + m * 2048 + k * 1024); } while (0)
#define PG8_LDB(dst, b, h) do { _Pragma("unroll") for (int n = 0; n < 2; ++n) _Pragma("unroll") for (int k = 0; k < 2; ++k) dst[n][k] = *(const LAS bf16x8*)(lds + PG8_SB(b, h) + boff + n * 2048 + k * 1024); } while (0)
#define PG8_MMA(ai, bj, At, Bt) do { __builtin_amdgcn_s_setprio(1); _Pragma("unroll") for (int m = 0; m < 4; ++m) _Pragma("unroll") for (int n = 0; n < 2; ++n) _Pragma("unroll") for (int k = 0; k < 2; ++k) \
        acc[ai][bj][m][n] = __builtin_amdgcn_mfma_f32_16x16x32_bf16(Bt[n][k], At[m][k], acc[ai][bj][m][n], 0, 0, 0); __builtin_amdgcn_s_setprio(0); } while (0)
#define PG8_WAIT_V(n) asm volatile("s_waitcnt vmcnt(" #n ")" ::: "memory")
#define PG8_WAIT_L(n) asm volatile("s_waitcnt lgkmcnt(" #n ")" ::: "memory")
#define PG8_BAR __builtin_amdgcn_s_barrier()
#define PG8_SCHED __builtin_amdgcn_sched_barrier(0)
    const Unit cur = g.u; int ui = 0;
    f32x4 acc[2][2][4][2];
#pragma unroll
    for (int a = 0; a < 2; ++a)
#pragma unroll
        for (int b = 0; b < 2; ++b)
#pragma unroll
            for (int m = 0; m < 4; ++m)
#pragma unroll
                for (int n = 0; n < 2; ++n) acc[a][b][m][n] = (f32x4){0.f, 0.f, 0.f, 0.f};
    bf16x8 At[4][2], B0[2][2], B1[2][2];
    const char* cA = (const char*)g.A[0] + (size_t)cur.pm * tstepA; const char* cB = (const char*)g.B[0] + (size_t)cur.pn * 2 * hstepB;
    PG8_STAGE(PG8_SB(0, 0), cB, voffB); PG8_STAGE(PG8_SB(0, 1), cB + hstepB, voffB); PG8_STAGE(PG8_SA(0, 0), cA, voffA); PG8_STAGE(PG8_SA(0, 1), cA + hstepA, voffA);
    if (wr == 1) PG8_BAR;
    PG8_WAIT_V(2); PG8_BAR;
    PG8_STAGE(PG8_SB(1, 0), cB + kstep, voffB); PG8_STAGE(PG8_SA(1, 0), cA + kstep, voffA); PG8_STAGE(PG8_SB(1, 1), cB + hstepB + kstep, voffB);
    PG8_WAIT_V(6); PG8_BAR;
    for (;;) {
        const bool has_next = ui < 2; const int un = has_next ? ui + 1 : ui;
        const bf16_t* An = un == 0 ? g.A[0] : (un == 1 ? g.A[1] : g.A[2]); const bf16_t* Bn = un == 0 ? g.B[0] : (un == 1 ? g.B[1] : g.B[2]);
        const int nt = g.K / BK;
        const char* nA = has_next ? (const char*)An + (size_t)cur.pm * tstepA : cA; const char* nB = has_next ? (const char*)Bn + (size_t)cur.pn * 2 * hstepB : cB;
        for (int t = 0; t < nt; t += 2) {
            const bool last = (t == nt - 2);
            const char* a1 = cA + (size_t)(t + 1) * kstep;
            const char* a2 = last ? nA : cA + (size_t)(t + 2) * kstep; const char* b2 = last ? nB : cB + (size_t)(t + 2) * kstep;
            const char* a3 = a2 + kstep; const char* b3 = b2 + kstep;
            PG8_LDB(B0, 0, 0); PG8_LDB(B1, 0, 1); PG8_SCHED; PG8_LDA(At, 0, 0); PG8_STAGE(PG8_SA(1, 1), a1 + hstepA, voffA);
            PG8_WAIT_V(8); PG8_WAIT_L(0); PG8_BAR; PG8_MMA(0, 0, At, B0); PG8_MMA(0, 1, At, B1); PG8_BAR; PG8_SCHED;
            PG8_LDA(At, 0, 1); PG8_STAGE(PG8_SB(0, 0), b2, voffB); PG8_STAGE(PG8_SB(0, 1), b2 + hstepB, voffB); PG8_STAGE(PG8_SA(0, 0), a2, voffA);
            PG8_WAIT_V(8); PG8_WAIT_L(0); PG8_BAR; PG8_MMA(1, 0, At, B0); PG8_MMA(1, 1, At, B1); PG8_BAR; PG8_SCHED;
            PG8_LDB(B0, 1, 0); PG8_LDB(B1, 1, 1); PG8_SCHED; PG8_LDA(At, 1, 0); PG8_STAGE(PG8_SA(0, 1), a2 + hstepA, voffA);
            PG8_WAIT_V(8); PG8_WAIT_L(0); PG8_BAR; PG8_MMA(0, 0, At, B0); PG8_MMA(0, 1, At, B1); PG8_BAR; PG8_SCHED;
            PG8_LDA(At, 1, 1); PG8_STAGE(PG8_SB(1, 0), b3, voffB); PG8_STAGE(PG8_SB(1, 1), b3 + hstepB, voffB); PG8_STAGE(PG8_SA(1, 0), a3, voffA);
            PG8_WAIT_V(8); PG8_WAIT_L(0); PG8_BAR; PG8_MMA(1, 0, At, B0); PG8_MMA(1, 1, At, B1); PG8_BAR; PG8_SCHED;
        }
        if (wr == 0) PG8_BAR;
        EF(acc, ui, cur, wr, wc, fr, fq);
        if (!has_next) break;
        cA = nA; cB = nB; ++ui;
        if (wr == 1) PG8_BAR;
    }
    PG8_WAIT_V(0);
    PG8_BAR;
#undef PG8_SA
#undef PG8_SB
#undef PG8_STAGE
#undef PG8_LDA
#undef PG8_LDB
#undef PG8_MMA
#undef PG8_WAIT_V
#undef PG8_WAIT_L
#undef PG8_BAR
#undef PG8_SCHED
}
}
using pg8::Unit;

struct Params {
    const float* x; const float* mem; const int* pos;
    const float *mix_g, *memn_g, *w_in, *aq_g, *ak_g, *dq_g, *dk_g, *eq_g, *ek_g, *w_memkv, *w_ba, *w_bd, *w_bm, *w_out, *ffn_g, *w_up, *conv_w, *conv_b, *w_down;
    float* out; unsigned char* ws;
};

struct EpiIn {
    int mode;
    bf16_t* proj; int ldp; bf16_t* gates; const float* rstd; const float* cosT; const float* sinT;
    const float *g_qa, *g_ka, *g_qd, *g_kd, *g_qm; float* kmean;
    DI void operator()(const f32x4 (&acc)[2][2][4][2], const Unit& u, int wr, int wc, int fr, int fq) const {
        const int cb = u.pn * 256 + wc * 64;
        const int row0 = u.pm * 256 + wr * 64 + fr;
        int kind; const float* gain = nullptr; float qs = 1.f; bool isk = false; bf16_t* ob = proj; int ldc = ldp; int oc = cb; int khead = 0;
        if (mode == 0) {
            if (cb < C_QM) { const int seg = cb / 384, hh = (cb - seg * 384) >> 6;
                if (seg == 0) { kind = 0; gain = g_qa; qs = C2; } else if (seg == 1) { kind = 0; gain = g_ka; isk = true; khead = hh; }
                else if (seg == 3) { kind = 0; gain = g_qd; qs = C2; } else if (seg == 4) { kind = 0; gain = g_kd; } else kind = 2;
                ob = proj + (size_t)(seg * 6 + hh) * HS; ldc = 64; oc = 0; }
            else if (cb < QKVW) { kind = 1; gain = g_qm; qs = C2; ob = proj + OFF_QM + (size_t)((cb - C_QM) >> 6) * HS; ldc = 64; oc = 0; }
            else { kind = 3; ob = gates; ldc = GW; oc = cb - QKVW; }
        } else { if (u.pn == 0) { kind = 1; gain = g_qa; } else kind = 2; }
        f32x4 gv[2][2];
#pragma unroll
        for (int bj = 0; bj < 2; ++bj)
#pragma unroll
            for (int n = 0; n < 2; ++n) gv[bj][n] = (kind <= 1) ? *(const f32x4*)(gain + 32 * bj + 8 * fq + 4 * n) : (f32x4){1.f, 1.f, 1.f, 1.f};
        f32x4 cs[2][2];
#pragma unroll
        for (int bj = 0; bj < 2; ++bj) { cs[bj][0] = (f32x4){0.f, 0.f, 0.f, 0.f}; cs[bj][1] = cs[bj][0]; }
#pragma unroll
        for (int ai = 0; ai < 2; ++ai)
#pragma unroll
            for (int m = 0; m < 4; ++m) {
                const int row = row0 + ai * 128 + m * 16;
                const float rs = rstd ? rstd[row] : 1.f;
                f32x4 v[2][2];
#pragma unroll
                for (int bj = 0; bj < 2; ++bj)
#pragma unroll
                    for (int n = 0; n < 2; ++n) v[bj][n] = acc[ai][bj][m][n] * rs;
                if (kind <= 1) {
                    float ss = 0.f;
#pragma unroll
                    for (int bj = 0; bj < 2; ++bj)
#pragma unroll
                        for (int n = 0; n < 2; ++n) { const f32x4 t = v[bj][n]; ss += (t[0] * t[0] + t[1] * t[1]) + (t[2] * t[2] + t[3] * t[3]); }
                    ss += __shfl_xor(ss, 16); ss += __shfl_xor(ss, 32);
                    const float inv = rsqrtf(ss * (1.f / 64.f) + EPS);
#pragma unroll
                    for (int bj = 0; bj < 2; ++bj)
#pragma unroll
                        for (int n = 0; n < 2; ++n) v[bj][n] = v[bj][n] * inv * gv[bj][n];
                    if (kind == 0) {
#pragma unroll
                        for (int n = 0; n < 2; ++n) {
                            const f32x4 c = *(const f32x4*)(cosT + (size_t)row * 32 + 8 * fq + 4 * n), s = *(const f32x4*)(sinT + (size_t)row * 32 + 8 * fq + 4 * n);
                            const f32x4 x1 = v[0][n], x2 = v[1][n];
                            v[0][n] = x1 * c - x2 * s; v[1][n] = x1 * s + x2 * c;
                        }
                    }
#pragma unroll
                    for (int bj = 0; bj < 2; ++bj)
#pragma unroll
                        for (int n = 0; n < 2; ++n) v[bj][n] = v[bj][n] * qs;
                    if (isk) {
#pragma unroll
                        for (int bj = 0; bj < 2; ++bj)
#pragma unroll
                            for (int n = 0; n < 2; ++n) cs[bj][n] += v[bj][n];
                    }
                } else if (kind == 3) {
#pragma unroll
                    for (int bj = 0; bj < 2; ++bj)
#pragma unroll
                        for (int n = 0; n < 2; ++n)
#pragma unroll
                            for (int j = 0; j < 4; ++j) v[bj][n][j] = fmaxf(__builtin_amdgcn_rcpf(1.f + __expf(-v[bj][n][j])), 1e-20f);
                }
                bf16_t* rp = ob + (size_t)row * ldc + oc + 8 * fq;
#pragma unroll
                for (int bj = 0; bj < 2; ++bj) { u32x4 w; w.x = pk2(v[bj][0][0], v[bj][0][1]); w.y = pk2(v[bj][0][2], v[bj][0][3]); w.z = pk2(v[bj][1][0], v[bj][1][1]); w.w = pk2(v[bj][1][2], v[bj][1][3]);
                    *(u32x4*)(rp + 32 * bj) = w; }
            }
        if (isk && kmean) {
#pragma unroll
            for (int bj = 0; bj < 2; ++bj)
#pragma unroll
                for (int n = 0; n < 2; ++n)
#pragma unroll
                    for (int j = 0; j < 4; ++j) { float t = cs[bj][n][j]; t += __shfl_xor(t, 1); t += __shfl_xor(t, 2); t += __shfl_xor(t, 4); t += __shfl_xor(t, 8);
                        if (fr == 0) atomicAdd(kmean + ((size_t)(khead * 64 + u.pm) * 64 + 32 * bj + 8 * fq + 4 * n + j), t * (1.f / 256.f)); }
        }
    }
};

struct EpiGate {
    bf16_t* merged; const bf16_t* gates; int gi; int first;
    DI void operator()(const f32x4 (&acc)[2][2][4][2], const Unit& u, int wr, int wc, int fr, int fq) const {
        const int row0 = u.pm * 256 + wr * 64 + fr, col = u.pn * 256 + wc * 64 + 8 * fq;
#pragma unroll
        for (int ai = 0; ai < 2; ++ai)
#pragma unroll
            for (int m = 0; m < 4; ++m) { const int row = row0 + ai * 128 + m * 16;
#pragma unroll
                for (int bj = 0; bj < 2; ++bj) {
                    const u32x4 g = *(const u32x4*)(gates + (size_t)row * GW + gi * 1024 + col + 32 * bj);
                    bf16_t* mp = merged + (size_t)row * DM + col + 32 * bj;
                    float o[8];
                    o[0] = acc[ai][bj][m][0][0] * bf_lo(g.x); o[1] = acc[ai][bj][m][0][1] * bf_hi(g.x); o[2] = acc[ai][bj][m][0][2] * bf_lo(g.y); o[3] = acc[ai][bj][m][0][3] * bf_hi(g.y);
                    o[4] = acc[ai][bj][m][1][0] * bf_lo(g.z); o[5] = acc[ai][bj][m][1][1] * bf_hi(g.z); o[6] = acc[ai][bj][m][1][2] * bf_lo(g.w); o[7] = acc[ai][bj][m][1][3] * bf_hi(g.w);
                    if (!first) { const u32x4 p = *(const u32x4*)mp;
                        o[0] += bf_lo(p.x); o[1] += bf_hi(p.x); o[2] += bf_lo(p.y); o[3] += bf_hi(p.y); o[4] += bf_lo(p.z); o[5] += bf_hi(p.z); o[6] += bf_lo(p.w); o[7] += bf_hi(p.w); }
                    u32x4 w; w.x = pk2(o[0], o[1]); w.y = pk2(o[2], o[3]); w.z = pk2(o[4], o[5]); w.w = pk2(o[6], o[7]);
                    *(u32x4*)mp = w; } }
    }
};

struct EpiGate3 { bf16_t* merged_; const bf16_t* gates_;
    DI void operator()(f32x4 (&acc)[2][2][4][2], int i, const Unit& u, int wr, int wc, int fr, int fq) const {
        const int row0 = u.pm * 256 + wr * 64 + fr, col = u.pn * 256 + wc * 64 + 8 * fq;
#pragma unroll
        for (int ai = 0; ai < 2; ++ai)
#pragma unroll
            for (int m = 0; m < 4; ++m) { const int row = row0 + ai * 128 + m * 16;
#pragma unroll
                for (int bj = 0; bj < 2; ++bj) {
                    const bf16_t* gp = gates_ + (size_t)row * GW + i * 1024 + col + 32 * bj;
                    const u32x4 ga = *(const u32x4*)gp;
#define G_LO(w) bf_lo(w)
#define G_HI(w) bf_hi(w)
                    if (i < 2) { const u32x4 gb = *(const u32x4*)(gp + 1024);
                        acc[ai][bj][m][0][0] *= G_LO(ga.x) * __builtin_amdgcn_rcpf(G_LO(gb.x)); acc[ai][bj][m][0][1] *= G_HI(ga.x) * __builtin_amdgcn_rcpf(G_HI(gb.x));
                        acc[ai][bj][m][0][2] *= G_LO(ga.y) * __builtin_amdgcn_rcpf(G_LO(gb.y)); acc[ai][bj][m][0][3] *= G_HI(ga.y) * __builtin_amdgcn_rcpf(G_HI(gb.y));
                        acc[ai][bj][m][1][0] *= G_LO(ga.z) * __builtin_amdgcn_rcpf(G_LO(gb.z)); acc[ai][bj][m][1][1] *= G_HI(ga.z) * __builtin_amdgcn_rcpf(G_HI(gb.z));
                        acc[ai][bj][m][1][2] *= G_LO(ga.w) * __builtin_amdgcn_rcpf(G_LO(gb.w)); acc[ai][bj][m][1][3] *= G_HI(ga.w) * __builtin_amdgcn_rcpf(G_HI(gb.w));
                    } else {
                        u32x4 w;
                        w.x = pk2(acc[ai][bj][m][0][0] * G_LO(ga.x), acc[ai][bj][m][0][1] * G_HI(ga.x)); w.y = pk2(acc[ai][bj][m][0][2] * G_LO(ga.y), acc[ai][bj][m][0][3] * G_HI(ga.y));
                        w.z = pk2(acc[ai][bj][m][1][0] * G_LO(ga.z), acc[ai][bj][m][1][1] * G_HI(ga.z)); w.w = pk2(acc[ai][bj][m][1][2] * G_LO(ga.w), acc[ai][bj][m][1][3] * G_HI(ga.w));
                        *(u32x4*)(merged_ + (size_t)row * DM + col + 32 * bj) = w; }
#undef G_LO
#undef G_HI
                    asm volatile("" ::: "memory");
                } }
    }
};

struct EpiRes1 {
    const float* x; float* x1; bf16_t* x1b; float* ssq;
    DI void operator()(const f32x4 (&acc)[2][2][4][2], const Unit& u, int wr, int wc, int fr, int fq) const {
        const int row0 = u.pm * 256 + wr * 64 + fr, col = u.pn * 256 + wc * 64 + 8 * fq;
#pragma unroll
        for (int ai = 0; ai < 2; ++ai)
#pragma unroll
            for (int m = 0; m < 4; ++m) { const int row = row0 + ai * 128 + m * 16; float ss = 0.f;
#pragma unroll
                for (int bj = 0; bj < 2; ++bj) { f32x4 v[2];
#pragma unroll
                    for (int n = 0; n < 2; ++n) { const size_t off = (size_t)row * DM + col + 32 * bj + 4 * n; v[n] = *(const f32x4*)(x + off) + acc[ai][bj][m][n];
                        ss += (v[n][0] * v[n][0] + v[n][1] * v[n][1]) + (v[n][2] * v[n][2] + v[n][3] * v[n][3]); }
                    u32x4 w; w.x = pk2(v[0][0], v[0][1]); w.y = pk2(v[0][2], v[0][3]); w.z = pk2(v[1][0], v[1][1]); w.w = pk2(v[1][2], v[1][3]);
                    *(u32x4*)(x1b + (size_t)row * DM + col + 32 * bj) = w; }
                ss += __shfl_xor(ss, 16); ss += __shfl_xor(ss, 32);
                if (fq == 0) ssq[(size_t)row * 16 + u.pn * 4 + wc] = ss; }
    }
};

struct EpiRes2 {
    float* out; const bf16_t* x1b; int store;
    DI void operator()(const f32x4 (&acc)[2][2][4][2], const Unit& u, int wr, int wc, int fr, int fq) const {
        const int row0 = u.pm * 256 + wr * 64 + fr, col = u.pn * 256 + wc * 64 + 8 * fq;
#pragma unroll
        for (int ai = 0; ai < 2; ++ai)
#pragma unroll
            for (int m = 0; m < 4; ++m) { const int row = row0 + ai * 128 + m * 16;
#pragma unroll
                for (int bj = 0; bj < 2; ++bj) { const size_t off = (size_t)row * DM + col + 32 * bj; const u32x4 r = *(const u32x4*)(x1b + off);
                    f32x4 v0 = acc[ai][bj][m][0], v1 = acc[ai][bj][m][1];
                    v0[0] += bf_lo(r.x); v0[1] += bf_hi(r.x); v0[2] += bf_lo(r.y); v0[3] += bf_hi(r.y); v1[0] += bf_lo(r.z); v1[1] += bf_hi(r.z); v1[2] += bf_lo(r.w); v1[3] += bf_hi(r.w);
                    if (store) { *(f32x4*)(out + off) = v0; *(f32x4*)(out + off + 4) = v1; } } }
    }
};

DI float dpp_ror1(float v) { return __builtin_bit_cast(float, __builtin_amdgcn_update_dpp(0, __builtin_bit_cast(int, v), 0x121, 0xf, 0xf, false)); }
DI float dpp_ror2(float v) { return __builtin_bit_cast(float, __builtin_amdgcn_update_dpp(0, __builtin_bit_cast(int, v), 0x122, 0xf, 0xf, false)); }

struct EpiConv {
    bf16_t* act; const float* ssq; const float* cw; const float* cbias;
    DI void operator()(const f32x4 (&acc)[2][2][4][2], const Unit& u, int wr, int wc, int fr, int fq) const {
        const int ca = u.pn * 128 + wc * 32 + 8 * fq;
        float rs[2][4];
#pragma unroll
        for (int ai = 0; ai < 2; ++ai) {
            const int tok0 = u.pm * 248 + 62 * (2 * ai + wr) + 4 * fr - 2;
#pragma unroll
            for (int m = 0; m < 4; ++m) { const int tok = tok0 + m; float r = 0.f;
                const bool okr = (tok >= 0 && tok < S);
                const f32x4 a = okr ? *(const f32x4*)(ssq + (size_t)tok * 16 + 4 * fq) : (f32x4){0.f, 0.f, 0.f, 0.f};
                float t = (a[0] + a[1]) + (a[2] + a[3]); t += __shfl_xor(t, 16); t += __shfl_xor(t, 32);
                if (okr) r = rsqrtf(t * (1.f / 1024.f) + EPS);
                rs[ai][m] = r; } }
        __builtin_amdgcn_sched_barrier(0);
        unsigned pkd[2][4][4];
#pragma unroll
        for (int n = 0; n < 2; ++n) {
            f32x4 w0[2], w1[2], w2[2], bb[2];
#pragma unroll
            for (int bj = 0; bj < 2; ++bj) { const int c = bj * FF + ca + 4 * n;
                w0[bj] = *(const f32x4*)(cw + c); w1[bj] = *(const f32x4*)(cw + 2 * FF + c); w2[bj] = *(const f32x4*)(cw + 4 * FF + c); bb[bj] = *(const f32x4*)(cbias + c); }
            asm volatile("" : "+v"(w0[0]), "+v"(w1[0]), "+v"(w2[0]), "+v"(bb[0]), "+v"(w0[1]), "+v"(w1[1]), "+v"(w2[1]), "+v"(bb[1]));
#pragma unroll
            for (int ai = 0; ai < 2; ++ai) {
#pragma unroll
                for (int j = 0; j < 4; ++j) {
                    float y[2][4];
#pragma unroll
                    for (int bj = 0; bj < 2; ++bj) {
                        float X[4], t2, t3;
#pragma unroll
                        for (int m = 0; m < 4; ++m) X[m] = acc[ai][bj][m][n][j] * rs[ai][m];
                        asm volatile("s_nop 1\n\t"
                                     "v_mov_b32_dpp %0, %2 row_shr:1 row_mask:0xf bank_mask:0xf\n\t"
                                     "v_mov_b32_dpp %1, %3 row_shr:1 row_mask:0xf bank_mask:0xf"
                                     : "=&v"(t2), "=&v"(t3) : "v"(X[2]), "v"(X[3]));
                        const float a0 = w0[bj][j], a1 = w1[bj][j], a2 = w2[bj][j], bv = bb[bj][j];
                        y[bj][0] = bv + a0 * t2 + a1 * t3 + a2 * X[0];
                        y[bj][1] = bv + a0 * t3 + a1 * X[0] + a2 * X[1];
                        y[bj][2] = bv + a0 * X[0] + a1 * X[1] + a2 * X[2];
                        y[bj][3] = bv + a0 * X[1] + a1 * X[2] + a2 * X[3];
                    }
#pragma unroll
                    for (int m = 0; m < 4; ++m) { const float gt = y[0][m], a = gt * __builtin_amdgcn_rcpf(1.f + __expf(-gt)) * y[1][m];
                        const unsigned short hb = (unsigned short)(pk2(a, 0.f) & 0xffffu);
                        const int e = 4 * n + j; if (e & 1) pkd[ai][m][e >> 1] |= ((unsigned)hb << 16); else pkd[ai][m][e >> 1] = hb;
                        asm volatile("" : "+v"(pkd[ai][m][e >> 1])); }
                    __builtin_amdgcn_sched_barrier(0);
                }
            }
            asm volatile("" ::: "memory");
        }
#pragma unroll
        for (int ai = 0; ai < 2; ++ai) {
            const int tok0 = u.pm * 248 + 62 * (2 * ai + wr) + 4 * fr - 2;
#pragma unroll
            for (int m = 0; m < 4; ++m) { const int tok = tok0 + m;
                if ((4 * fr + m) >= 2 && tok < S) { u32x4 w; w.x = pkd[ai][m][0]; w.y = pkd[ai][m][1]; w.z = pkd[ai][m][2]; w.w = pkd[ai][m][3]; *(u32x4*)(act + (size_t)tok * FF + ca) = w; } } }
    }
};

DI int perm_generic(int c) { const int u = c >> 8, cl = c & 255, wc = cl >> 6, bj = (cl >> 5) & 1, fq = (cl >> 3) & 3, n = (cl >> 2) & 1, j = cl & 3; return (u << 8) + 128 * bj + 32 * wc + 16 * n + 4 * fq + j; }
DI int perm_up(int c) { const int bj = c >= FF ? 1 : 0, a = c - FF * bj, pn = a >> 7, al = a & 127, wc = al >> 5, fq = (al >> 3) & 3, n = (al >> 2) & 1, j = al & 3; return (pn << 8) + 128 * bj + 32 * wc + 16 * n + 4 * fq + j; }
DI float wave_sum(float v) {
#pragma unroll
    for (int o = 1; o < 64; o <<= 1) v += __shfl_xor(v, o);
    return v; }
DI float wave_max(float v) {
#pragma unroll
    for (int o = 1; o < 64; o <<= 1) v = fmaxf(v, __shfl_xor(v, o));
    return v; }
DI void p0_transpose_item(const float* W, int K, int N, const float* gain, bf16_t* WT, int up, LAS float* scr, int item, int lane, int ldt = 0) {
    const int nblk = N / 32, kb = item / nblk, nb = item % nblk, k0 = 64 * kb, n0 = 32 * nb;
    const int c4 = lane & 7, r0 = lane >> 3;
    f32x4 w[8];
#pragma unroll
    for (int i = 0; i < 8; ++i) w[i] = *(const f32x4*)(W + (size_t)(k0 + r0 + 8 * i) * N + n0 + 4 * c4);
#pragma unroll
    for (int i = 0; i < 8; ++i) { const int kk = r0 + 8 * i; f32x4 v = w[i]; if (gain) v = v * gain[k0 + kk];
        LAS float* d = scr + kk * 33 + 4 * c4; d[0] = v[0]; d[1] = v[1]; d[2] = v[2]; d[3] = v[3]; }
    asm volatile("s_waitcnt lgkmcnt(0)" ::: "memory");
    const int c = lane & 7;
#pragma unroll
    for (int j = 0; j < 4; ++j) { const int n = (lane >> 3) + 8 * j; const LAS float* s = scr + (8 * c) * 33 + n;
        u32x4 o; o.x = pk2(s[0 * 33], s[1 * 33]); o.y = pk2(s[2 * 33], s[3 * 33]); o.z = pk2(s[4 * 33], s[5 * 33]); o.w = pk2(s[6 * 33], s[7 * 33]);
        const int rowp = up ? perm_up(n0 + n) : perm_generic(n0 + n);
        *(u32x4*)(WT + (size_t)rowp * (ldt ? ldt : K) + k0 + 8 * c) = o; }
    asm volatile("s_waitcnt lgkmcnt(0)" ::: "memory");
}

#define MFMA32(a, b, c) __builtin_amdgcn_mfma_f32_32x32x16_bf16((a), (b), (c), 0, 0, 0)
DI int crow(int i, int h) { return (i & 3) + 8 * (i >> 2) + 4 * h; }
DI s16x4 vtr(const LAS unsigned char* p) { return __builtin_bit_cast(s16x4, __builtin_amdgcn_ds_read_tr16_b64_v4i16((LAS s16x4*)p)); }
constexpr int KP = 144;

DI void pv_tile(const float (&p)[16], const LAS unsigned char* vt, f32x16 (&o)[2], int lane) {
    const int h = lane >> 5, i16 = lane & 15, q = i16 >> 2, pp = i16 & 3, blk = (lane >> 4) & 1;
    bf16x8 pb[2];
#pragma unroll
    for (int sp = 0; sp < 2; ++sp) { u32x4 w; w.x = pk2(p[8 * sp + 0], p[8 * sp + 1]); w.y = pk2(p[8 * sp + 2], p[8 * sp + 3]); w.z = pk2(p[8 * sp + 4], p[8 * sp + 5]); w.w = pk2(p[8 * sp + 6], p[8 * sp + 7]); pb[sp] = __builtin_bit_cast(bf16x8, w); }
#pragma unroll
    for (int dh = 0; dh < 2; ++dh)
#pragma unroll
        for (int sp = 0; sp < 2; ++sp) {
            const LAS unsigned char* a0 = vt + (16 * sp + 4 * h + q) * KP + 2 * (32 * dh + 16 * blk) + 8 * pp;
            const s16x4 lo = vtr(a0), hi = vtr(a0 + 8 * KP);
            const bf16x8 vf = __builtin_shufflevector(lo, hi, 0, 1, 2, 3, 4, 5, 6, 7);
            o[dh] = MFMA32(vf, pb[sp], o[dh]);
        }
}

DI float softmax_bound(const float* gq, const float* gk, int lane) { const float a = wave_max(fabsf(gq[lane])), b = wave_max(fabsf(gk[lane])); const float r = 64.f * a * b * C2;
    return __builtin_bit_cast(float, __builtin_amdgcn_readfirstlane(__builtin_bit_cast(int, r))); }

struct BAUnit { const bf16_t* Kg; const bf16_t* Vg; int kpitch; const bf16_t* Q; int qpitch; int q0; const unsigned* list; int count; int head; int nvalid; bf16_t* O; int opitch; };
struct BAPref { u32x4 k[4], v[4]; bf16x8 qf[4]; unsigned ent; int qrow; bool valid; };
template <int MODE>
DI void ba_issue(BAPref& f, const BAUnit& u, int tid, int wave, int r32, int h) {
#pragma unroll
    for (int i = 0; i < 4; ++i) { const int c = tid + 512 * i, row = c >> 3, cc = c & 7;
        f.k[i] = *(const u32x4*)(u.Kg + (size_t)row * u.kpitch + 8 * cc); f.v[i] = *(const u32x4*)(u.Vg + (size_t)row * u.kpitch + 8 * cc); }
    f.ent = 0u; f.valid = true;
    if (MODE == 1) { const int idx = 32 * wave + r32; f.valid = idx < u.count; f.ent = f.valid ? u.list[idx] : 0u; f.qrow = (int)(f.ent >> 2); }
    else f.qrow = u.q0 + 32 * wave + r32;
#pragma unroll
    for (int s = 0; s < 4; ++s) f.qf[s] = *(const bf16x8*)(u.Q + (size_t)f.qrow * u.qpitch + 16 * s + 8 * h);
}
template <int MODE, class NextF>
DI void block_attn_loop(LAS unsigned char* lds, const NextF& next, float negM, bf16_t* slotO, float* slotL, bool do_store) {
    int tid_ = threadIdx.x; asm volatile("" : "+v"(tid_));
    const int tid = tid_, lane = tid & 63, wave = __builtin_amdgcn_readfirstlane(tid >> 6), r32 = lane & 31, h = lane >> 5;
    LAS unsigned char* Kl = lds; LAS unsigned char* Vl = lds + 256 * KP;
    BAUnit cur, nxt; int ui = 0;
    if (!next(0, cur)) return;
    BAPref f; ba_issue<MODE>(f, cur, tid, wave, r32, h);
    f32x16 negm;
#pragma unroll
    for (int i = 0; i < 16; ++i) negm[i] = negM;
    for (;;) {
#pragma unroll
        for (int i = 0; i < 4; ++i) { const int c = tid + 512 * i, row = c >> 3, cc = c & 7;
            *(LAS u32x4*)(Kl + row * KP + 16 * cc) = f.k[i]; *(LAS u32x4*)(Vl + row * KP + 16 * cc) = f.v[i]; }
        bf16x8 qf[4];
#pragma unroll
        for (int s = 0; s < 4; ++s) qf[s] = f.qf[s];
        const unsigned ent = f.ent; const int qrow = f.qrow; const bool valid = f.valid;
        asm volatile("" : "+v"(qf[0]), "+v"(qf[1]), "+v"(qf[2]), "+v"(qf[3]));
        __syncthreads();
        const bool has_next = next(ui + 1, nxt);
        if (has_next) ba_issue<MODE>(f, nxt, tid, wave, r32, h);
        f32x16 o[2]; float l = 0.f;
#pragma unroll
        for (int i = 0; i < 16; ++i) { o[0][i] = 0.f; o[1][i] = 0.f; }
        const int ntile = (MODE == 2) ? wave + 1 : 8;
#pragma unroll 2
        for (int kt = 0; kt < ntile; ++kt) {
            f32x16 sacc = negm;
#pragma unroll
            for (int s = 0; s < 4; ++s) { const bf16x8 kf = *(const LAS bf16x8*)(Kl + (32 * kt + r32) * KP + 2 * (16 * s + 8 * h)); sacc = MFMA32(kf, qf[s], sacc); }
            float p[16];
#pragma unroll
            for (int i = 0; i < 16; ++i) { float e = __builtin_amdgcn_exp2f(sacc[i]); if (MODE == 2) { if (kt == wave && crow(i, h) > r32) e = 0.f; } p[i] = e; l += e; }
            pv_tile(p, Vl + 32 * kt * KP, o, lane);
        }
        l += __shfl_xor(l, 32);
        if (MODE == 1) {
            if (valid) { const int slot = (int)(ent & 3u); const size_t sb = ((size_t)qrow * 6 + cur.head) * 3 + slot;
#pragma unroll
                for (int dh = 0; dh < 2; ++dh)
#pragma unroll
                    for (int g = 0; g < 4; ++g) { u32x2 w; w.x = pk2(o[dh][4 * g], o[dh][4 * g + 1]); w.y = pk2(o[dh][4 * g + 2], o[dh][4 * g + 3]); *(u32x2*)(slotO + sb * 64 + 32 * dh + 8 * g + 4 * h) = w; }
                if (h == 0) slotL[sb] = l; }
        } else {
            if (MODE == 2) {
                for (int sl = 0; sl < cur.nvalid; ++sl) { const size_t sb = ((size_t)qrow * 6 + cur.head) * 3 + sl;
#pragma unroll
                    for (int dh = 0; dh < 2; ++dh)
#pragma unroll
                        for (int g = 0; g < 4; ++g) { const u32x2 w = *(const u32x2*)(slotO + sb * 64 + 32 * dh + 8 * g + 4 * h);
                            o[dh][4 * g] += bf_lo(w.x); o[dh][4 * g + 1] += bf_hi(w.x); o[dh][4 * g + 2] += bf_lo(w.y); o[dh][4 * g + 3] += bf_hi(w.y); }
                    l += slotL[sb]; }
            }
            const float il = __builtin_amdgcn_rcpf(l);
            if (do_store)
#pragma unroll
            for (int dh = 0; dh < 2; ++dh)
#pragma unroll
                for (int g = 0; g < 4; ++g) { u32x2 w; w.x = pk2(o[dh][4 * g] * il, o[dh][4 * g + 1] * il); w.y = pk2(o[dh][4 * g + 2] * il, o[dh][4 * g + 3] * il);
                    *(u32x2*)(cur.O + (size_t)qrow * cur.opitch + 32 * dh + 8 * g + 4 * h) = w; }
        }
        __syncthreads();
        if (!has_next) break;
        cur = nxt; ++ui;
    }
}

struct DilState { int r, g, sh, kb0, kstep, ntile, qpos, t0, lim, koff, vcol; int voff[4]; bf16x8 qf[4]; bf16x8 kfn[4]; u32x4 vn[4]; };
DI void dil_load(DilState& s, const bf16_t* Kh, const bf16_t* Vh, int T, int h) {
    const int kb_ = s.kb0 + s.kstep * T; int kp_ = kb_ + s.koff; kp_ = kp_ < 0 ? 0 : kp_;
#pragma unroll
    for (int q = 0; q < 4; ++q) s.kfn[q] = *(const bf16x8*)(Kh + (size_t)kp_ * 64 + 16 * q + 8 * h);
#pragma unroll
    for (int i = 0; i < 4; ++i) { int vp_ = kb_ + s.voff[i]; vp_ = vp_ < 0 ? 0 : vp_; s.vn[i] = *(const u32x4*)(Vh + (size_t)vp_ * 64 + s.vcol); }
}
DI void dil_setup(DilState& s, int pi, const bf16_t* Qh, const bf16_t* Kh, const bf16_t* Vh, int P0, int lane, int wave) {
    const int r32 = lane & 31, h = lane >> 5;
    s.r = pi == 0 ? 1 : (pi == 1 ? 4 : 16); s.g = pi == 2 ? 2 : 1; s.sh = s.g - 1;
    int qb;
    if (pi == 0) { qb = P0 + 32 * wave; s.kb0 = qb - 128; s.kstep = 32; s.ntile = 5; }
    else if (pi == 1) { qb = P0 + (wave >> 1) + 128 * (wave & 1); s.kb0 = qb - 512; s.kstep = 128; s.ntile = 5; }
    else { qb = P0 + 2 * wave; s.kb0 = qb - 2048; s.kstep = 256; s.ntile = 9; }
    s.qpos = qb + (r32 & (s.g - 1)) + s.r * (r32 >> s.sh);
#pragma unroll
    for (int q = 0; q < 4; ++q) s.qf[q] = *(const bf16x8*)(Qh + (size_t)s.qpos * 64 + 16 * q + 8 * h);
    const int maxoff = (s.g - 1) + s.r * (31 >> s.sh);
    int t0 = 0; while (t0 < s.ntile && s.kb0 + s.kstep * t0 + maxoff < 0) ++t0;
    s.t0 = t0;
    s.lim = min(128 * s.r, s.qpos);
    s.koff = (r32 & (s.g - 1)) + s.r * (r32 >> s.sh);
#pragma unroll
    for (int i = 0; i < 4; ++i) { const int row = (lane >> 3) + 8 * i; s.voff[i] = (row & (s.g - 1)) + s.r * (row >> s.sh); }
    s.vcol = 8 * (lane & 7);
    if (t0 < s.ntile) dil_load(s, Kh, Vh, t0, h);
}
DI void dil_run(DilState& s, const bf16_t* Kh, const bf16_t* Vh, LAS unsigned char* vst0, const float negM, f32x16 (&o)[2], float& l, int lane) {
    const int h = lane >> 5;
    int offi[16];
#pragma unroll
    for (int i = 0; i < 16; ++i) { const int row = crow(i, h); offi[i] = (row & (s.g - 1)) + s.r * (row >> s.sh); }
#pragma unroll
    for (int i = 0; i < 16; ++i) { o[0][i] = 0.f; o[1][i] = 0.f; }
    l = 0.f;
#pragma unroll 2
    for (int t = s.t0; t < s.ntile; ++t) {
        LAS unsigned char* vst = vst0 + (t & 1) * (32 * KP);
        bf16x8 kf[4]; u32x4 vv[4];
#pragma unroll
        for (int q = 0; q < 4; ++q) { kf[q] = s.kfn[q]; vv[q] = s.vn[q]; }
        asm volatile("" : "+v"(kf[0]), "+v"(kf[1]), "+v"(kf[2]), "+v"(kf[3]));
        asm volatile("" : "+v"(vv[0]), "+v"(vv[1]), "+v"(vv[2]), "+v"(vv[3]));
        if (t + 1 < s.ntile) dil_load(s, Kh, Vh, t + 1, h);
#pragma unroll
        for (int i = 0; i < 4; ++i) *(LAS u32x4*)(vst + ((lane >> 3) + 8 * i) * KP + 2 * s.vcol) = vv[i];
        f32x16 sacc;
#pragma unroll
        for (int i = 0; i < 16; ++i) sacc[i] = 0.f;
#pragma unroll
        for (int q = 0; q < 4; ++q) sacc = MFMA32(kf[q], s.qf[q], sacc);
        const int dq = s.qpos - (s.kb0 + s.kstep * t);
        float p[16];
#pragma unroll
        for (int i = 0; i < 16; ++i) { const int d = dq - offi[i];
            const bool ok = ((unsigned)d <= (unsigned)s.lim) && ((d & (s.r - 1)) == 0);
            const float e = ok ? __builtin_amdgcn_exp2f(sacc[i] + negM) : 0.f; p[i] = e; l += e; }
        pv_tile(p, vst, o, lane);
    }
    l += __shfl_xor(l, 32);
}
DI void dil_accum(LAS float* accl, bool first, int ql, const f32x16 (&o)[2], float l, int h) {
    if (first) {
#pragma unroll
        for (int dh = 0; dh < 2; ++dh)
#pragma unroll
            for (int i = 0; i < 16; ++i) accl[ql * 65 + 32 * dh + crow(i, h)] = o[dh][i];
        if (h == 0) accl[ql * 65 + 64] = l;
    } else {
#pragma unroll
        for (int dh = 0; dh < 2; ++dh)
#pragma unroll
            for (int i = 0; i < 16; ++i) accl[ql * 65 + 32 * dh + crow(i, h)] += o[dh][i];
        if (h == 0) accl[ql * 65 + 64] += l;
    }
}
DI void dilated_unit(LAS unsigned char* lds, const bf16_t* proj, bf16_t* aout, int hd, int P0, float negM, bool do_store = true) {
    int tid_ = threadIdx.x; asm volatile("" : "+v"(tid_));
    const int tid = tid_, lane = tid & 63, wave = __builtin_amdgcn_readfirstlane(tid >> 6), h = lane >> 5;
    LAS float* accl = (LAS float*)lds;
    LAS unsigned char* vst0 = lds + 256 * 65 * 4 + wave * (2 * 32 * KP);
    const bf16_t* Qh = proj + OFF_QD + (size_t)hd * HS; const bf16_t* Kh = proj + OFF_KD + (size_t)hd * HS; const bf16_t* Vh = proj + OFF_VD + (size_t)hd * HS;
    DilState A, B; f32x16 o[2]; float l;
    dil_setup(A, 0, Qh, Kh, Vh, P0, lane, wave);
    dil_run(A, Kh, Vh, vst0, negM, o, l, lane);
    dil_setup(B, 1, Qh, Kh, Vh, P0, lane, wave);
    dil_accum(accl, true, A.qpos - P0, o, l, h);
    __syncthreads();
    dil_run(B, Kh, Vh, vst0, negM, o, l, lane);
    dil_setup(A, 2, Qh, Kh, Vh, P0, lane, wave);
    dil_accum(accl, false, B.qpos - P0, o, l, h);
    __syncthreads();
    dil_run(A, Kh, Vh, vst0, negM, o, l, lane);
    dil_accum(accl, false, A.qpos - P0, o, l, h);
    __syncthreads();
    if (do_store) { const int ql = tid >> 1, half = tid & 1; const float il = 1.f / accl[ql * 65 + 64];
        bf16_t* op = aout + (size_t)(P0 + ql) * DM + 384 + hd * 64 + 32 * half;
#pragma unroll
        for (int c = 0; c < 4; ++c) { float v[8];
#pragma unroll
            for (int e = 0; e < 8; ++e) v[e] = accl[ql * 65 + 32 * half + 8 * c + e] * il;
            u32x4 w; w.x = pk2(v[0], v[1]); w.y = pk2(v[2], v[3]); w.z = pk2(v[4], v[5]); w.w = pk2(v[6], v[7]); *(u32x4*)(op + 8 * c) = w; } }
    __syncthreads();
}

DI void top3_insert(float v, int idx, float& b0, float& b1, float& b2, int& i0, int& i1, int& i2) {
    const bool c0 = (v > b0) || (v == b0 && idx < i0), c1 = (v > b1) || (v == b1 && idx < i1), c2 = (v > b2) || (v == b2 && idx < i2);
    const float nb2 = c1 ? b1 : (c2 ? v : b2); const int ni2 = c1 ? i1 : (c2 ? idx : i2);
    const float nb1 = c0 ? b0 : (c1 ? v : b1); const int ni1 = c0 ? i0 : (c1 ? idx : i1);
    const float nb0 = c0 ? v : b0; const int ni0 = c0 ? idx : i0;
    b0 = nb0; b1 = nb1; b2 = nb2; i0 = ni0; i1 = ni1; i2 = ni2;
}
DI void select_unit(LAS unsigned char* lds, const bf16_t* proj, const float* kmean, unsigned* cnt, unsigned* lists, int hd, int n, bool do_store = true) {
    int tid_ = threadIdx.x; asm volatile("" : "+v"(tid_));
    const int tid = tid_, lane = tid & 63, wave = __builtin_amdgcn_readfirstlane(tid >> 6), r32 = lane & 31, h = lane >> 5;
    LAS unsigned char* Khi = lds; LAS unsigned char* Klo = lds + 64 * KP;
    LAS unsigned* hist = (LAS unsigned*)(lds + 32768);
    { const int row = tid >> 3, c8 = tid & 7; const float* kp = kmean + ((size_t)hd * 64 + row) * 64 + 8 * c8;
      const f32x4 x0 = *(const f32x4*)kp, x1 = *(const f32x4*)(kp + 4);
      u32x4 hv, lv;
      hv.x = pk2(x0[0], x0[1]); lv.x = pk2(x0[0] - bf_lo(hv.x), x0[1] - bf_hi(hv.x));
      hv.y = pk2(x0[2], x0[3]); lv.y = pk2(x0[2] - bf_lo(hv.y), x0[3] - bf_hi(hv.y));
      hv.z = pk2(x1[0], x1[1]); lv.z = pk2(x1[0] - bf_lo(hv.z), x1[1] - bf_hi(hv.z));
      hv.w = pk2(x1[2], x1[3]); lv.w = pk2(x1[2] - bf_lo(hv.w), x1[3] - bf_hi(hv.w));
      *(LAS u32x4*)(Khi + row * KP + 16 * c8) = hv;
      *(LAS u32x4*)(Klo + row * KP + 16 * c8) = lv; }
    if (tid < 128) hist[tid] = 0u;
    const int q = 256 * n + 32 * wave + r32;
    bf16x8 qf[4];
#pragma unroll
    for (int s = 0; s < 4; ++s) qf[s] = *(const bf16x8*)(proj + OFF_QA + (size_t)hd * HS + (size_t)q * 64 + 16 * s + 8 * h);
    __syncthreads();
    f32x16 g0, g1;
#pragma unroll
    for (int i = 0; i < 16; ++i) { g0[i] = 0.f; g1[i] = 0.f; }
#pragma unroll
    for (int s = 0; s < 4; ++s) { const int co = 2 * (16 * s + 8 * h);
        const bf16x8 a0 = *(const LAS bf16x8*)(Khi + r32 * KP + co), a1 = *(const LAS bf16x8*)(Klo + r32 * KP + co);
        const bf16x8 c0 = *(const LAS bf16x8*)(Khi + (32 + r32) * KP + co), c1 = *(const LAS bf16x8*)(Klo + (32 + r32) * KP + co);
        g0 = MFMA32(a0, qf[s], g0); g0 = MFMA32(a1, qf[s], g0); g1 = MFMA32(c0, qf[s], g1); g1 = MFMA32(c1, qf[s], g1); }
    float b0 = -INFINITY, b1 = -INFINITY, b2 = -INFINITY; int i0 = -1, i1 = -1, i2 = -1;
#pragma unroll
    for (int i = 0; i < 16; ++i) { const int blk = crow(i, h); const bool okb = blk < n; top3_insert(okb ? g0[i] : -INFINITY, okb ? blk : 1000, b0, b1, b2, i0, i1, i2); }
#pragma unroll
    for (int i = 0; i < 16; ++i) { const int blk = 32 + crow(i, h); const bool okb = blk < n; top3_insert(okb ? g1[i] : -INFINITY, okb ? blk : 1000, b0, b1, b2, i0, i1, i2); }
    {
        const float ob0 = __shfl_xor(b0, 32), ob1 = __shfl_xor(b1, 32), ob2 = __shfl_xor(b2, 32); const int oi0 = __shfl_xor(i0, 32), oi1 = __shfl_xor(i1, 32), oi2 = __shfl_xor(i2, 32);
        top3_insert(oi0 >= 0 ? ob0 : -INFINITY, oi0 >= 0 ? oi0 : 1000, b0, b1, b2, i0, i1, i2);
        top3_insert(oi1 >= 0 ? ob1 : -INFINITY, oi1 >= 0 ? oi1 : 1000, b0, b1, b2, i0, i1, i2);
        top3_insert(oi2 >= 0 ? ob2 : -INFINITY, oi2 >= 0 ? oi2 : 1000, b0, b1, b2, i0, i1, i2);
    }
    unsigned lr0 = 0u, lr1 = 0u, lr2 = 0u;
    if (h == 0) {
        if (i0 >= 0) lr0 = __hip_atomic_fetch_add(hist + i0, 1u, __ATOMIC_RELAXED, __HIP_MEMORY_SCOPE_WORKGROUP);
        if (i1 >= 0) lr1 = __hip_atomic_fetch_add(hist + i1, 1u, __ATOMIC_RELAXED, __HIP_MEMORY_SCOPE_WORKGROUP);
        if (i2 >= 0) lr2 = __hip_atomic_fetch_add(hist + i2, 1u, __ATOMIC_RELAXED, __HIP_MEMORY_SCOPE_WORKGROUP);
    }
    __syncthreads();
    if (tid < n) { const unsigned c = hist[tid]; hist[64 + tid] = (c && do_store) ? atomicAdd(cnt + hd * 64 + tid, c) : 0u; }
    __syncthreads();
    if (h == 0 && do_store) {
        unsigned* lh = lists + (size_t)hd * LIST_PER_HEAD;
        if (i0 >= 0) lh[list_off(i0) + hist[64 + i0] + lr0] = ((unsigned)q << 2) | 0u;
        if (i1 >= 0) lh[list_off(i1) + hist[64 + i1] + lr1] = ((unsigned)q << 2) | 1u;
        if (i2 >= 0) lh[list_off(i2) + hist[64 + i2] + lr2] = ((unsigned)q << 2) | 2u;
    }
    __syncthreads();
}

struct OneBA { BAUnit u0; DI bool operator()(int i, BAUnit& u) const { if (i) return false; u = u0; return true; } };
struct MemNext { bf16_t* mkv_; bf16_t* proj_; bf16_t* ao_; int e0, stride, n;
    DI bool operator()(int i, BAUnit& u) const { const int e = e0 + stride * i; if (e >= n) return false; const int hm = e >> 6, qt = e & 63;
        u.Kg = mkv_ + hm * 64; u.Vg = mkv_ + 256 + hm * 64; u.kpitch = 512; u.Q = proj_ + OFF_QM + (size_t)hm * HS; u.qpitch = 64; u.q0 = qt * 256; u.list = nullptr; u.count = 0; u.head = 0; u.nvalid = 0; u.O = ao_ + 768 + hm * 64; u.opitch = DM; return true; } };
struct GathNext { LAS int* pre; int T, bx, G; const unsigned* cnt_; bf16_t* proj_; const unsigned* lists_;
    DI bool operator()(int i, BAUnit& u) const { const int ui = bx + i * G; if (ui >= T) return false;
        int e, t, c;
        if (i < 16) { e = pre[512 + 3 * i]; t = pre[513 + 3 * i]; c = pre[514 + 3 * i]; }
        else { int lo = 0, hi = 377; while (lo < hi) { const int mid = (lo + hi) >> 1; if (pre[mid] > ui) hi = mid; else lo = mid + 1; }
               e = lo; t = ui - (e ? pre[e - 1] : 0); c = (int)cnt_[(e / 63) * 64 + e % 63]; }
        const int hd = e / 63, n = e % 63;
        u.Kg = proj_ + OFF_KA + (size_t)hd * HS + (size_t)(256 * n) * 64; u.Vg = proj_ + OFF_VA + (size_t)hd * HS + (size_t)(256 * n) * 64; u.kpitch = 64; u.Q = proj_ + OFF_QA + (size_t)hd * HS; u.qpitch = 64; u.q0 = 0; u.O = nullptr; u.opitch = 0;
        u.list = lists_ + (size_t)hd * LIST_PER_HEAD + list_off(n) + 256 * t; u.count = c - 256 * t; u.head = hd; u.nvalid = 0; return true; } };
struct OwnNext { int bx, G; bf16_t* proj_; bf16_t* ao_;
    DI bool operator()(int i, BAUnit& u) const { const int ui = bx + i * G; if (ui >= 6 * 64) return false; const int hd = ui >> 6, n = 63 - (ui & 63);
        u.Kg = proj_ + OFF_KA + (size_t)hd * HS + (size_t)(256 * n) * 64; u.Vg = proj_ + OFF_VA + (size_t)hd * HS + (size_t)(256 * n) * 64; u.kpitch = 64; u.Q = proj_ + OFF_QA + (size_t)hd * HS; u.qpitch = 64; u.q0 = 256 * n; u.O = ao_ + hd * 64; u.opitch = DM;
        u.list = nullptr; u.count = 0; u.head = hd; u.nvalid = n < 3 ? n : 3; return true; } };

#define XB_TMO      128
#define XB_XCNT(j)  (256  + 64 * (j))
#define XB_XSUB(j)  (1280 + 64 * (j))
#define XB_XGEN(j)  (2304 + 64 * (j))
#define XB_TOP      3328
#define XB_TOPGEN   3392
#define XCD_BAR_WORDS 3456
#define XB_SPIN_CAP (1u << 18)
DI unsigned xb_ld(unsigned* p)              { return __hip_atomic_load(p, __ATOMIC_RELAXED, __HIP_MEMORY_SCOPE_AGENT); }
DI unsigned xb_add(unsigned* p, unsigned v) { return __hip_atomic_fetch_add(p, v, __ATOMIC_RELAXED, __HIP_MEMORY_SCOPE_AGENT); }
DI unsigned xb_xcc_id() { return (unsigned)__builtin_amdgcn_s_getreg((3 << 11) | 20) & 0xFu; }
#define XB_SPIN(cond, bar) do { unsigned _sp = 0; while (cond) { __builtin_amdgcn_s_sleep(1); \
    if ((++_sp & 255u) == 0u) { if (xb_ld(&(bar)[XB_TMO])) break; if (_sp > XB_SPIN_CAP) { atomicAdd(&(bar)[XB_TMO], 1u); break; } } } } while (0)
struct XcdBarrier { unsigned* bar; unsigned x; volatile LAS unsigned* st; };
DI XcdBarrier xcd_barrier_post(unsigned* bar, volatile LAS unsigned* st) {
    XcdBarrier b; b.bar = bar; b.x = xb_xcc_id(); b.st = st;
    if (threadIdx.x == 0) (void)xb_add(&bar[XB_XCNT(b.x)], 1u);
    return b;
}
DI void xcd_barrier_complete(unsigned* bar, unsigned x, unsigned& nloc, unsigned& nx) {
    const unsigned G = gridDim.x * gridDim.y * gridDim.z;
    unsigned sum, cnt_, mine, sp = 0u;
    for (;;) {
        sum = 0u; cnt_ = 0u; mine = 0u;
#pragma unroll
        for (unsigned j = 0; j < 16; ++j) { const unsigned c = xb_ld(&bar[XB_XCNT(j)]); sum += c; cnt_ += (c > 0u) ? 1u : 0u; mine = (j == x) ? c : mine; }
        if (sum == G) break;
        __builtin_amdgcn_s_sleep(1);
        if ((++sp & 255u) == 0u) { if (xb_ld(&bar[XB_TMO])) break; if (sp > XB_SPIN_CAP) { atomicAdd(&bar[XB_TMO], 1u); break; } }
    }
    nloc = mine > 0u ? mine : 1u; nx = cnt_ > 0u ? cnt_ : 1u;
}
DI void xcd_barrier(const XcdBarrier& b) {
    asm volatile("s_waitcnt vmcnt(0)" ::: "memory");
    __syncthreads();
    if (threadIdx.x == 0) {
        unsigned* bar = b.bar;
        __builtin_amdgcn_s_waitcnt(0);
        unsigned nloc = b.st[0], nx = b.st[1];
        if (nloc == 0u) { xcd_barrier_complete(bar, b.x, nloc, nx); b.st[0] = nloc; b.st[1] = nx; }
        const unsigned old = xb_add(&bar[XB_XSUB(b.x)], 1u);
        const unsigned gen = old / nloc;
        if (old + 1u == (gen + 1u) * nloc) {
            __builtin_amdgcn_fence(__ATOMIC_RELEASE, "agent");
            asm volatile("s_waitcnt vmcnt(0)" ::: "memory");
            const unsigned og = xb_add(&bar[XB_TOP], 1u);
            const unsigned tg = og / nx;
            if (og + 1u == (tg + 1u) * nx) xb_add(&bar[XB_TOPGEN], 1u);
            else XB_SPIN(xb_ld(&bar[XB_TOPGEN]) == tg, bar);
            __builtin_amdgcn_fence(__ATOMIC_ACQUIRE, "agent");
            xb_add(&bar[XB_XGEN(b.x)], 1u);
            asm volatile("s_waitcnt vmcnt(0)" ::: "memory");
        } else {
            XB_SPIN(xb_ld(&bar[XB_XGEN(b.x)]) == gen, bar);
            __builtin_amdgcn_fence(__ATOMIC_ACQUIRE, "agent");
            asm volatile("s_waitcnt vmcnt(0)" ::: "memory");
        }
    }
    __syncthreads();
}

DI int ltid() { int t = threadIdx.x; asm volatile("" : "+v"(t)); return t; }
typedef const __attribute__((address_space(4))) Params* KParams;
DI KParams kpar() { KParams q = (KParams)__builtin_amdgcn_kernarg_segment_ptr(); asm volatile("" : "+s"(q)); return q; }
DI unsigned char* wsb_() { unsigned char* w = kpar()->ws; asm volatile("" : "+s"(w)); return w; }
DI unsigned char* outb_() { unsigned char* w = (unsigned char*)kpar()->out; asm volatile("" : "+s"(w)); return w; }
#define wsb(p_) wsb_()
#define outb(p_) outb_()
#define XBAR_NOW (XcdBarrier{(unsigned*)(wsb_() + WS_CTL + CTL_BAR), xb_xcc_id(), (volatile LAS unsigned*)(lds + LDS_BYTES - 64)})
#define p (*kpar())
__global__ void __launch_bounds__(512, 2) fwd_megakernel(Params p_arg) {
    extern __shared__ __attribute__((aligned(16))) unsigned char lds_raw[];
    LAS unsigned char* lds = (LAS unsigned char*)lds_raw;
    cg::grid_group grid = cg::this_grid();
    const int G = gridDim.x, bx = blockIdx.x;
    { const int tid = threadIdx.x;
    if (tid < 4) ((volatile LAS unsigned*)(lds + LDS_BYTES - 64))[tid] = 0u;
    __syncthreads();
    }
    (void)xcd_barrier_post((unsigned*)(p.ws + WS_CTL + CTL_BAR), (volatile LAS unsigned*)(lds + LDS_BYTES - 64));
    unsigned char* ws = p.ws;
#define cnt ((unsigned*)(wsb(p) + WS_CTL + CTL_CNT))
#define kmean ((float*)(wsb(p) + WS_CTL + CTL_KMEAN))
#define rstd1 ((float*)(wsb(p) + WS_RSTD1))
#define ssq2 ((float*)(wsb(p) + WS_SSQ2))
#define cosT ((float*)(wsb(p) + WS_COS))
#define sinT ((float*)(wsb(p) + WS_SIN))
#define memn ((bf16_t*)(wsb(p) + WS_MEMN))
#define mkv ((bf16_t*)(wsb(p) + WS_MKV))
#define w_in_t ((bf16_t*)(wsb(p) + WS_WIN))
#define w_up_t ((bf16_t*)(wsb(p) + WS_WUP))
#define w_down_t ((bf16_t*)(wsb(p) + WS_WDOWN))
#define w_out_t ((bf16_t*)(wsb(p) + WS_WOUT))
#define w_ba_t ((bf16_t*)(wsb(p) + WS_WBA))
#define w_bd_t ((bf16_t*)(wsb(p) + WS_WBD))
#define w_bm_t ((bf16_t*)(wsb(p) + WS_WBM))
#define w_mkv_t ((bf16_t*)(wsb(p) + WS_WMKV))
#define xb ((bf16_t*)(wsb(p) + WS_XB))
#define merged ((bf16_t*)(wsb(p) + WS_PROJ))
#define attn_out ((bf16_t*)(wsb(p) + WS_XB))
#define proj ((bf16_t*)(wsb(p) + WS_PROJ))
#define x1b ((bf16_t*)(wsb(p) + WS_XB))
#define gates ((bf16_t*)(wsb(p) + WS_GATES))
#define act ((bf16_t*)(wsb(p) + WS_GATES))
#define slotO ((bf16_t*)(outb(p) + DO_SLOTO))
#define slotL ((float*)(outb(p) + DO_SLOTL))
#define lists ((unsigned*)(outb(p) + DO_LIST))

    for (int rep_ = 0; rep_ < REP_P0; ++rep_) {
    {
        const int tid = ltid(), lane = tid & 63, wave = __builtin_amdgcn_readfirstlane(tid >> 6); (void)lane; (void)wave;
        LAS float* scr = (LAS float*)(lds + wave * 16384);
        const int gw = bx * 8 + wave, NGW = G * 8;
        constexpr int I_IN = 16 * 176, I_MKV = 16 * 16;
        for (int it = gw; it < I_IN + I_MKV; it += NGW) {
            if (it < I_IN) p0_transpose_item(p.w_in, DM, INC, p.mix_g, w_in_t, 0, scr, it, lane);
            else p0_transpose_item(p.w_memkv, DM, 512, nullptr, w_mkv_t, 0, scr, it - I_IN, lane);
        }
        for (int m0 = 2 * gw; m0 < S + NMEM; m0 += 2 * NGW) {
            f32x4 v[2][4]; float s[2];
#pragma unroll
            for (int q = 0; q < 2; ++q) { const int m = m0 + q; const float* src_ = (m >= S) ? p.mem + (size_t)(m - S) * DM : p.x + (size_t)m * DM;
                const f32x4* xr = (const f32x4*)src_ + lane;
#pragma unroll
                for (int j = 0; j < 4; ++j) v[q][j] = xr[64 * j]; }
#pragma unroll
            for (int q = 0; q < 2; ++q) { float t = 0.f;
#pragma unroll
                for (int j = 0; j < 4; ++j) t += (v[q][j][0] * v[q][j][0] + v[q][j][1] * v[q][j][1]) + (v[q][j][2] * v[q][j][2] + v[q][j][3] * v[q][j][3]);
                s[q] = t; }
#pragma unroll
            for (int q = 0; q < 2; ++q) { const int m = m0 + q; const bool ismem = m >= S;
                const float rstd = rsqrtf(wave_sum(s[q]) * (1.f / DM) + EPS);
                bf16_t* dst = ismem ? memn + (size_t)(m - S) * DM : xb + (size_t)m * DM;
                if (ismem) {
#pragma unroll
                    for (int j = 0; j < 4; ++j) { const f32x4 gg = *((const f32x4*)p.memn_g + lane + 64 * j); v[q][j] = v[q][j] * rstd * gg; }
                } else if (lane == 0) rstd1[m] = rstd;
#pragma unroll
                for (int j = 0; j < 4; ++j) { u32x2 w; w.x = pk2(v[q][j][0], v[q][j][1]); w.y = pk2(v[q][j][2], v[q][j][3]); *((u32x2*)dst + lane + 64 * j) = w; } }
        }
        { const float inv_freq = powf(10000.f, -(float)(tid & 31) / 32.f);
          for (int i = bx * 512 + tid; i < S * 32; i += G * 512) { const int t = i >> 5;
            const float ang = (float)p.pos[t] * inv_freq; float sn, cs; sincosf(ang, &sn, &cs);
            cosT[i] = cs; sinT[i] = sn; } }
        for (int i = bx * 512 + tid; i < (int)((CTL_KMEAN + 6 * 64 * 64 * 4) / 4); i += G * 512) ((unsigned*)(wsb_() + WS_CTL))[i] = 0u;
    }
    if (gridDim.y > 1) grid.sync();
    xcd_barrier(XBAR_NOW);

    }
    for (int rep_ = 0; rep_ < REP_P1; ++rep_) {
    {
        const int tid = ltid(), lane = tid & 63, wave = __builtin_amdgcn_readfirstlane(tid >> 6); (void)lane; (void)wave;
        pg8::Gemm g{xb, w_in_t, S, INC, DM, DM, 0}; pg8::StaticOrder So; So.init(S, INC, G, bx);
        EpiIn E{0, proj, QKVW, gates, rstd1, cosT, sinT, p.aq_g, p.ak_g, p.dq_g, p.dk_g, p.eq_g, (rep_ == REP_P1 - 1) ? kmean : nullptr};
        pg8::gemm_phase<EpiIn, pg8::StaticOrder>(lds, g, So, E);
        pg8::Gemm g2{memn, w_mkv_t, NMEM, 512, DM, DM, 0}; pg8::OneUnit O1; O1.have = (bx >= G - 2) ? 1 : 0; O1.u0.pm = 0; O1.u0.pn = bx - (G - 2);
        EpiIn E2{1, mkv, 512, nullptr, nullptr, nullptr, nullptr, p.ek_g, nullptr, nullptr, nullptr, nullptr, nullptr};
        pg8::gemm_phase<EpiIn, pg8::OneUnit>(lds, g2, O1, E2);
    }
    xcd_barrier(XBAR_NOW);

    }
    for (int rep_ = 0; rep_ < REP_P2; ++rep_) {
    {
        const int tid = ltid(), lane = tid & 63, wave = __builtin_amdgcn_readfirstlane(tid >> 6); (void)lane; (void)wave;
        const float negD = -softmax_bound(p.dq_g, p.dk_g, lane), negE = -softmax_bound(p.eq_g, p.ek_g, lane);
        constexpr int NU_D = 6 * 64, NU_E = 4 * 64, NU_S = 6 * 63;
        const bool last_rep = (rep_ == REP_P2 - 1);
        if (G == 256) {
            const int xc = bx & 7, xi = bx >> 3, vb = xc * 32 + xi, li = xc * 16 + (xi >> 1);
            dilated_unit(lds, proj, attn_out, vb >> 6, (vb & 63) * 256, negD, last_rep);
            if (!(xi & 1)) { const int ui = 256 + li; dilated_unit(lds, proj, attn_out, ui >> 6, (ui & 63) * 256, negD, last_rep); }
            else {
                { MemNext mn{mkv, proj, attn_out, li, 128, NU_E}; block_attn_loop<0>(lds, mn, negE, nullptr, nullptr, last_rep); }
                for (int e = li; e < NU_S; e += 128) { const int hd = e / 63, n = 1 + e % 63; select_unit(lds, proj, kmean, cnt, lists, hd, n, last_rep); }
            }
        } else
        for (int ui = bx; ui < NU_D + NU_E + NU_S; ui += G) {
            if (ui < NU_D) { dilated_unit(lds, proj, attn_out, ui >> 6, (ui & 63) * 256, negD, last_rep); }
            else if (ui < NU_D + NU_E) { MemNext mn{mkv, proj, attn_out, ui - NU_D, 1 << 20, NU_E}; block_attn_loop<0>(lds, mn, negE, nullptr, nullptr, last_rep); }
            else { const int e = ui - NU_D - NU_E, hd = e / 63, n = 1 + e % 63; select_unit(lds, proj, kmean, cnt, lists, hd, n, last_rep); }
        }
    }
    xcd_barrier(XBAR_NOW);
    }
    for (int rep_ = 0; rep_ < REP_P3; ++rep_) {
    {
        const int tid = ltid(), lane = tid & 63, wave = __builtin_amdgcn_readfirstlane(tid >> 6); (void)lane; (void)wave;
        const float negA = -softmax_bound(p.aq_g, p.ak_g, lane);
        LAS int* pre = (LAS int*)(lds + 81920);
        { int v = 0; if (tid < 378) { const int hd = tid / 63, n = tid % 63; v = ((int)cnt[hd * 64 + n] + 255) >> 8; }
          pre[tid] = v; __syncthreads();
          for (int off = 1; off < 512; off <<= 1) { const int a = (tid >= off) ? pre[tid - off] : 0; __syncthreads(); pre[tid] += a; __syncthreads(); } }
        const int T = pre[377];
        const int vb = (G == 256) ? (bx & 7) * 32 + (bx >> 3) : bx;
        if (tid < 16) { const int ui = vb + tid * G;
            if (ui < T) { int lo = 0, hi = 377; while (lo < hi) { const int mid = (lo + hi) >> 1; if (pre[mid] > ui) hi = mid; else lo = mid + 1; }
                pre[512 + 3 * tid] = lo; pre[513 + 3 * tid] = ui - (lo ? pre[lo - 1] : 0); pre[514 + 3 * tid] = (int)cnt[(lo / 63) * 64 + lo % 63]; } }
        __syncthreads();
        { GathNext gn{pre, T, vb, G, cnt, proj, lists}; block_attn_loop<1>(lds, gn, negA, slotO, slotL, true); }
    }
    xcd_barrier(XBAR_NOW);

    }
    for (int rep_ = 0; rep_ < REP_P3B; ++rep_) {
    {
        const int tid = ltid(), lane = tid & 63, wave = __builtin_amdgcn_readfirstlane(tid >> 6); (void)lane; (void)wave;
        const float negA = -softmax_bound(p.aq_g, p.ak_g, lane);
        {
            constexpr int I_UP = 16 * 176, I_DN = 44 * 32, I_OUT = 16 * 32, I_BA = 6 * 32, I_BD = 6 * 32, I_BM = 4 * 32, NIT2 = I_UP + I_DN + I_OUT + I_BA + I_BD + I_BM;
            LAS float* scr = (LAS float*)(lds + wave * 16384);
            const int nw = (G > 128) ? (G - 128) * 8 : G * 8, w0 = (G > 128) ? (bx - 128) * 8 + wave : bx * 8 + wave;
            if (G <= 128 || bx >= 128)
            for (int it = w0; it < NIT2; it += nw) {
                int r = it;
                if (r < I_UP) { p0_transpose_item(p.w_up, DM, INC, p.ffn_g, w_up_t, 1, scr, r, lane); continue; } r -= I_UP;
                if (r < I_DN) { p0_transpose_item(p.w_down, FF, DM, nullptr, w_down_t, 0, scr, r, lane); continue; } r -= I_DN;
                if (r < I_OUT) { p0_transpose_item(p.w_out, DM, DM, nullptr, w_out_t, 0, scr, r, lane); continue; } r -= I_OUT;
                if (r < I_BA) { p0_transpose_item(p.w_ba, 384, DM, nullptr, w_ba_t, 0, scr, r, lane); continue; } r -= I_BA;
                if (r < I_BD) { p0_transpose_item(p.w_bd, 384, DM, nullptr, w_bd_t, 0, scr, r, lane); continue; } r -= I_BD;
                p0_transpose_item(p.w_bm, 256, DM, nullptr, w_bm_t, 0, scr, r, lane, 384);
            }
            if (G <= 128 || bx >= 128) for (int i = w0 * 64 + lane; i < 1024 * 16; i += nw * 64) { const int rw = i >> 4, cc = i & 15; *(u32x4*)(w_bm_t + (size_t)rw * 384 + 256 + 8 * cc) = (u32x4){0u, 0u, 0u, 0u}; }
            __syncthreads();
        }
        { OwnNext on{bx, G, proj, attn_out}; block_attn_loop<2>(lds, on, negA, slotO, slotL, rep_ == REP_P3B - 1); }
    }
    xcd_barrier(XBAR_NOW);

    }
    for (int rep_ = 0; rep_ < REP_P4; ++rep_) {
    {
        const int tid = ltid(), lane = tid & 63, wave = __builtin_amdgcn_readfirstlane(tid >> 6); (void)lane; (void)wave;
        pg8::StaticOrder So; So.init(S, DM, G, bx);
        for (int i = 0; ; ++i) { pg8::Unit u; if (!So.next(i, u)) break;
            pg8::Chain3 g; g.A[0] = attn_out; g.A[1] = attn_out + 384; g.A[2] = attn_out + 768; g.B[0] = w_ba_t; g.B[1] = w_bd_t; g.B[2] = w_bm_t; g.K = 384; g.lda = DM; g.u = u;
            EpiGate3 E{merged, gates}; pg8::gemm_chain3<EpiGate3>(lds, g, E); }
    }
    xcd_barrier(XBAR_NOW);

    }
    for (int rep_ = 0; rep_ < REP_P5; ++rep_) {
    {
        const int tid = ltid(), lane = tid & 63, wave = __builtin_amdgcn_readfirstlane(tid >> 6); (void)lane; (void)wave;
        if (bx == 0) { for (int i = tid; i < 1024; i += 512) ((unsigned*)(ws + WS_XB - 4096))[i] = 0u; }
        pg8::Gemm g{merged, w_out_t, S, DM, DM, DM, 0}; pg8::StaticOrder So; So.init(S, DM, G, bx);
        EpiRes1 E{p.x, p.out, x1b, ssq2}; pg8::gemm_phase<EpiRes1, pg8::StaticOrder>(lds, g, So, E);
    }
    xcd_barrier(XBAR_NOW);

    }
    for (int rep_ = 0; rep_ < REP_P6; ++rep_) {
    {
        const int tid = ltid(), lane = tid & 63, wave = __builtin_amdgcn_readfirstlane(tid >> 6); (void)lane; (void)wave;
        pg8::Gemm g{x1b - 2 * DM, w_up_t, 67 * 256, INC, DM, DM, 1}; pg8::StaticOrder So; So.init(67 * 256, INC, G, bx);
        EpiConv E{act, ssq2, p.conv_w, p.conv_b}; pg8::gemm_phase<EpiConv, pg8::StaticOrder>(lds, g, So, E);
    }
    xcd_barrier(XBAR_NOW);

    }
    for (int rep_ = 0; rep_ < REP_P7; ++rep_) {
    {
        const int tid = ltid(), lane = tid & 63, wave = __builtin_amdgcn_readfirstlane(tid >> 6); (void)lane; (void)wave;
        pg8::Gemm g{act, w_down_t, S, DM, FF, FF, 0}; pg8::StaticOrder So; So.init(S, DM, G, bx);
        EpiRes2 E{p.out, x1b, rep_ == REP_P7 - 1 ? 1 : 0}; pg8::gemm_phase<EpiRes2, pg8::StaticOrder>(lds, g, So, E);
    }
    if (rep_ + 1 < REP_P7) xcd_barrier(XBAR_NOW);
    }
}

#undef p
extern "C" void kernel_launch(void* const* d_in, const int* in_sizes, int n_in, void* d_out, int out_size, void* d_ws, size_t ws_size, hipStream_t stream) {
    static int grid = 0;
    if (grid == 0) {
        if (n_in != 22 || ws_size < WS_END) { fprintf(stderr, "kernel_launch: unexpected inputs (n_in %d, ws %zu)\n", n_in, ws_size); grid = -1; return; }
        int dev = 0, cus = 0, per_cu = 0;
        hipGetDevice(&dev); hipDeviceGetAttribute(&cus, hipDeviceAttributeMultiprocessorCount, dev);
        hipFuncSetAttribute((const void*)fwd_megakernel, hipFuncAttributeMaxDynamicSharedMemorySize, LDS_BYTES);
        hipOccupancyMaxActiveBlocksPerMultiprocessor(&per_cu, (const void*)fwd_megakernel, 512, LDS_BYTES);
        if (per_cu < 1) per_cu = 1;
        grid = cus * 1;
        (void)hipGetLastError();
    }
    if (grid < 0) return;
    hipMemsetAsync((char*)d_ws + WS_CTL + CTL_BAR, 0, 16384, stream);
    Params p{};
    p.x = (const float*)d_in[0]; p.mem = (const float*)d_in[1]; p.pos = (const int*)d_in[2];
    p.mix_g = (const float*)d_in[3]; p.memn_g = (const float*)d_in[4]; p.w_in = (const float*)d_in[5];
    p.aq_g = (const float*)d_in[6]; p.ak_g = (const float*)d_in[7]; p.dq_g = (const float*)d_in[8]; p.dk_g = (const float*)d_in[9];
    p.eq_g = (const float*)d_in[10]; p.ek_g = (const float*)d_in[11]; p.w_memkv = (const float*)d_in[12];
    p.w_ba = (const float*)d_in[13]; p.w_bd = (const float*)d_in[14]; p.w_bm = (const float*)d_in[15]; p.w_out = (const float*)d_in[16];
    p.ffn_g = (const float*)d_in[17]; p.w_up = (const float*)d_in[18]; p.conv_w = (const float*)d_in[19]; p.conv_b = (const float*)d_in[20]; p.w_down = (const float*)d_in[21];
    p.out = (float*)d_out; p.ws = (unsigned char*)d_ws;
    void* args[] = {&p};
    hipError_t e = hipLaunchCooperativeKernel((const void*)fwd_megakernel, dim3(grid), dim3(512), args, LDS_BYTES, stream);
    if (e != hipSuccess) fprintf(stderr, "cooperative launch failed: %s (grid %d)\n", hipGetErrorString(e), grid);
}
```

```cpp
#include <hip/hip_runtime.h>
#include <hip/hip_cooperative_groups.h>
#include <cstdio>
#include <cstdint>
namespace cg = cooperative_groups;

#define DI __device__ __forceinline__
#define LAS __attribute__((address_space(3)))
typedef unsigned short bf16_t;
typedef short bf16x8 __attribute__((ext_vector_type(8)));
typedef short s16x4 __attribute__((ext_vector_type(4)));
typedef float f32x4 __attribute__((ext_vector_type(4)));
typedef float f32x16 __attribute__((ext_vector_type(16)));
typedef unsigned u32x4 __attribute__((ext_vector_type(4)));
typedef unsigned u32x2 __attribute__((ext_vector_type(2)));
typedef float f32x2_t __attribute__((ext_vector_type(2)));
typedef __bf16 bf16x2_t __attribute__((ext_vector_type(2)));

DI int my_shfl_xor(int v, int k) { int l = (int)__lane_id(); asm volatile("" : "+v"(l)); return __builtin_amdgcn_ds_bpermute((l ^ k) << 2, v); }
DI float my_shfl_xor(float v, int k) { return __builtin_bit_cast(float, my_shfl_xor(__builtin_bit_cast(int, v), k)); }
#define __shfl_xor(v, k) my_shfl_xor((v), (k))
DI unsigned pk2(float lo, float hi) { f32x2_t v = {lo, hi}; bf16x2_t b = __builtin_convertvector(v, bf16x2_t); return __builtin_bit_cast(unsigned, b); }
DI float bf_lo(unsigned w) { return __uint_as_float(w << 16); }
DI float bf_hi(unsigned w) { return __uint_as_float(w & 0xffff0000u); }

constexpr int S = 16384, DM = 1024, INC = 5632, QKVW = 2560, GW = 3072, FF = 2816, NMEM = 256;
constexpr float EPS = 1e-6f;
constexpr float C2 = 0.125f * 1.4426950408889634f;
constexpr int C_QA = 0, C_KA = 384, C_VA = 768, C_QD = 1152, C_KD = 1536, C_VD = 1920, C_QM = 2304;
constexpr size_t HS = (size_t)S * 64;
constexpr size_t OFF_QA = 0, OFF_KA = 6 * HS, OFF_VA = 12 * HS, OFF_QD = 18 * HS, OFF_KD = 24 * HS, OFF_VD = 30 * HS, OFF_QM = 36 * HS;

constexpr size_t MiB = 1u << 20;
constexpr size_t WS_CTL = 0, CTL_ZERO_BYTES = 1 * MiB;
constexpr size_t CTL_CNT = 0;
constexpr size_t CTL_KMEAN = 4096;
constexpr size_t CTL_BAR = 512 * 1024;
constexpr size_t WS_RSTD1 = 1 * MiB;
constexpr size_t WS_SSQ2 = 1 * MiB + 128 * 1024;
constexpr size_t WS_COS = 3 * MiB, WS_SIN = 5 * MiB;
constexpr size_t WS_MEMN = 7 * MiB;
constexpr size_t WS_MKV = 7 * MiB + 512 * 1024;
constexpr size_t WS_WIN = 8 * MiB, WS_WUP = 19 * MiB, WS_WDOWN = 30 * MiB, WS_WOUT = 36 * MiB;
constexpr size_t WS_WBA = 38 * MiB, WS_WBD = 38 * MiB + 768 * 1024, WS_WBM = 41 * MiB, WS_WMKV = 40 * MiB;
constexpr size_t WS_XB = 42 * MiB;
constexpr size_t WS_PROJ = 76 * MiB;
constexpr size_t WS_GATES = 158 * MiB;
constexpr size_t WS_END = 254 * MiB;
constexpr size_t DO_SLOTO = 0;
constexpr size_t DO_SLOTL = 36 * MiB;
constexpr size_t DO_LIST = 38 * MiB;
constexpr int LIST_PER_HEAD = 516096;
DI int list_off(int n) { return n * S - 128 * n * (n + 1); }

constexpr int LDS_BYTES = 147456;
#ifndef REP_P0
#define REP_P0 1
#endif
#ifndef REP_P3
#define REP_P3 1
#endif
#ifndef REP_P4
#define REP_P4 1
#endif
#ifndef REP_P1
#define REP_P1 1
#endif
#ifndef REP_P2
#define REP_P2 1
#endif
#ifndef REP_P3B
#define REP_P3B 1
#endif
#ifndef REP_P7
#define REP_P7 1
#endif
#ifndef REP_P5
#define REP_P5 1
#endif
#ifndef REP_P6
#define REP_P6 1
#endif


namespace pg8 {
constexpr int BM = 256, BK = 64, HALF = 128, HTB = HALF * BK * 2, STAGE_BYTES = 8 * HTB, NXCD = 8, WGM = 8;
__host__ __device__ __forceinline__ int lds_byte(int r, int c) { const int st = (r >> 4) * 2 + (c >> 5), rr = r & 15, cc = c & 31, ob = rr * 64 + cc * 2; return st * 1024 + (ob ^ (((ob >> 9) & 1) << 5)); }
__host__ __device__ __forceinline__ void stage_rc(int b, int& R, int& C) { const int st = b / 1024, sb = b % 1024, swz = sb ^ (((sb >> 9) & 1) << 5); R = (st >> 1) * 16 + swz / 64; C = (st & 1) * 32 + (swz % 64) / 2; }
struct Unit { int pm, pn; };
struct Gemm { const bf16_t* A; const bf16_t* Bt; int M, N, K, lda, halo; };
struct StaticOrder {
    int nM, nN, nwg, G, c;
    DI void init(int M, int N, int G_, int c_) { nM = M / BM; nN = N / BM; nwg = nM * nN; G = G_; c = c_; }
    DI bool next(int i, Unit& u) const {
        const long L = (long)i * G + c; if (L >= nwg) return false;
        int wgid = (int)L; { const int q = nwg / NXCD, r = nwg % NXCD, xcd = wgid % NXCD, off = wgid / NXCD; wgid = (xcd < r ? xcd * (q + 1) : r * (q + 1) + (xcd - r) * q) + off; }
        const int nig = WGM * nN, gid = wgid / nig, fm = gid * WGM, gsz = (nM - fm) < WGM ? (nM - fm) : WGM;
        u.pm = fm + ((wgid % nig) % gsz); u.pn = (wgid % nig) / gsz; return true;
    }
};
struct OneUnit { int have; Unit u0; DI bool next(int i, Unit& u) const { if (i == 0 && have) { u = u0; return true; } return false; } };

template <class Epi, class Sched>
DI void gemm_phase(LAS unsigned char* lds, const Gemm g, const Sched& S, const Epi& E) {
    int tid_ = threadIdx.x; asm volatile("" : "+v"(tid_));
    const int tid = tid_, wid = __builtin_amdgcn_readfirstlane(tid >> 6), lane = tid & 63, wr = wid >> 2, wc = wid & 3, fr = lane & 15, fq = lane >> 4;
    const int K = g.K, nt = K / BK;
    unsigned voffA[2], voffB[2];
#pragma unroll
    for (int i = 0; i < 2; ++i) { int R, C; stage_rc(tid * 16 + i * 8192, R, C); const int Ra = g.halo ? (62 * (R >> 6) + 4 * (R & 15) + ((R >> 4) & 3)) : R;
        voffA[i] = (unsigned)(Ra * g.lda + C) * 2u; voffB[i] = (unsigned)(R * K + C) * 2u; }
    const size_t kstep = (size_t)(BK * 2);
    const size_t hstepA = (size_t)(g.halo ? 124 : 128) * g.lda * 2, tstepA = 2 * hstepA;
    const size_t hstepB = (size_t)HALF * K * 2, tstepB = 2 * hstepB;
    const unsigned ldsw = (unsigned)wid * 1024u;
    const int aoff = lds_byte(wr * 64 + fr, fq * 8), boff = lds_byte(wc * 32 + fr, fq * 8);
#define PG8_SA(b, h) (((b) * 2 + (h)) * HTB)
#define PG8_SB(b, h) ((4 + (b) * 2 + (h)) * HTB)
#define PG8_STAGE(bufoff, gbase, voff) do { _Pragma("unroll") for (int _i = 0; _i < 2; ++_i) \
        __builtin_amdgcn_global_load_lds((const unsigned*)((const char*)(gbase) + (voff)[_i]), (LAS unsigned*)(lds + (bufoff) + ldsw + _i * 8192), 16, 0, 0); } while (0)
#define PG8_LDA(dst, b, h) do { _Pragma("unroll") for (int m = 0; m < 4; ++m) _Pragma("unroll") for (int k = 0; k < 2; ++k) dst[m][k] = *(const LAS bf16x8*)(lds + PG8_SA(b, h) + aoff + m * 2048 + k * 1024); } while (0)
#define PG8_LDB(dst, b, h) do { _Pragma("unroll") for (int n = 0; n < 2; ++n) _Pragma("unroll") for (int k = 0; k < 2; ++k) dst[n][k] = *(const LAS bf16x8*)(lds + PG8_SB(b, h) + boff + n * 2048 + k * 1024); } while (0)
#define PG8_MMA(ai, bj, At, Bt) do { __builtin_amdgcn_s_setprio(1); _Pragma("unroll") for (int m = 0; m < 4; ++m) _Pragma("unroll") for (int n = 0; n < 2; ++n) _Pragma("unroll") for (int k = 0; k < 2; ++k) \
        acc[ai][bj][m][n] = __builtin_amdgcn_mfma_f32_16x16x32_bf16(Bt[n][k], At[m][k], acc[ai][bj][m][n], 0, 0, 0); __builtin_amdgcn_s_setprio(0); } while (0)
#define PG8_WAIT_V(n) asm volatile("s_waitcnt vmcnt(" #n ")" ::: "memory")
#define PG8_WAIT_L(n) asm volatile("s_waitcnt lgkmcnt(" #n ")" ::: "memory")
#define PG8_BAR __builtin_amdgcn_s_barrier()
#define PG8_SCHED __builtin_amdgcn_sched_barrier(0)
    Unit cur, nxt; int ui = 0;
    if (!S.next(0, cur)) return;
    f32x4 acc[2][2][4][2];
#pragma unroll
    for (int a = 0; a < 2; ++a)
#pragma unroll
        for (int b = 0; b < 2; ++b)
#pragma unroll
            for (int m = 0; m < 4; ++m)
#pragma unroll
                for (int n = 0; n < 2; ++n) acc[a][b][m][n] = (f32x4){0.f, 0.f, 0.f, 0.f};
    bf16x8 At[4][2], B0[2][2], B1[2][2];
    const char* cA = (const char*)g.A + (size_t)cur.pm * tstepA; const char* cB = (const char*)g.Bt + (size_t)cur.pn * tstepB;
    PG8_STAGE(PG8_SB(0, 0), cB, voffB); PG8_STAGE(PG8_SB(0, 1), cB + hstepB, voffB); PG8_STAGE(PG8_SA(0, 0), cA, voffA); PG8_STAGE(PG8_SA(0, 1), cA + hstepA, voffA);
    if (wr == 1) PG8_BAR;
    PG8_WAIT_V(2); PG8_BAR;
    PG8_STAGE(PG8_SB(1, 0), cB + kstep, voffB); PG8_STAGE(PG8_SA(1, 0), cA + kstep, voffA); PG8_STAGE(PG8_SB(1, 1), cB + hstepB + kstep, voffB);
    PG8_WAIT_V(6); PG8_BAR;
    for (;;) {
        const bool has_next = S.next(ui + 1, nxt);
        const char* nA = has_next ? (const char*)g.A + (size_t)nxt.pm * tstepA : cA; const char* nB = has_next ? (const char*)g.Bt + (size_t)nxt.pn * tstepB : cB;
        for (int t = 0; t < nt; t += 2) {
            const bool last = (t == nt - 2);
            const char* a1 = cA + (size_t)(t + 1) * kstep;
            const char* a2 = last ? nA : cA + (size_t)(t + 2) * kstep; const char* b2 = last ? nB : cB + (size_t)(t + 2) * kstep;
            const char* a3 = a2 + kstep; const char* b3 = b2 + kstep;
            PG8_LDB(B0, 0, 0); PG8_LDB(B1, 0, 1); PG8_SCHED; PG8_LDA(At, 0, 0); PG8_STAGE(PG8_SA(1, 1), a1 + hstepA, voffA);
            PG8_WAIT_V(8); PG8_WAIT_L(0); PG8_BAR; PG8_MMA(0, 0, At, B0); PG8_MMA(0, 1, At, B1); PG8_BAR; PG8_SCHED;
            PG8_LDA(At, 0, 1); PG8_STAGE(PG8_SB(0, 0), b2, voffB); PG8_STAGE(PG8_SB(0, 1), b2 + hstepB, voffB); PG8_STAGE(PG8_SA(0, 0), a2, voffA);
            PG8_WAIT_V(8); PG8_WAIT_L(0); PG8_BAR; PG8_MMA(1, 0, At, B0); PG8_MMA(1, 1, At, B1); PG8_BAR; PG8_SCHED;
            PG8_LDB(B0, 1, 0); PG8_LDB(B1, 1, 1); PG8_SCHED; PG8_LDA(At, 1, 0); PG8_STAGE(PG8_SA(0, 1), a2 + hstepA, voffA);
            PG8_WAIT_V(8); PG8_WAIT_L(0); PG8_BAR; PG8_MMA(0, 0, At, B0); PG8_MMA(0, 1, At, B1); PG8_BAR; PG8_SCHED;
            PG8_LDA(At, 1, 1); PG8_STAGE(PG8_SB(1, 0), b3, voffB); PG8_STAGE(PG8_SB(1, 1), b3 + hstepB, voffB); PG8_STAGE(PG8_SA(1, 0), a3, voffA);
            PG8_WAIT_V(8); PG8_WAIT_L(0); PG8_BAR; PG8_MMA(1, 0, At, B0); PG8_MMA(1, 1, At, B1); PG8_BAR; PG8_SCHED;
        }
        if (wr == 0) PG8_BAR;
        E(acc, cur, wr, wc, fr, fq);
        if (!has_next) break;
#pragma unroll
        for (int a = 0; a < 2; ++a)
#pragma unroll
            for (int b = 0; b < 2; ++b)
#pragma unroll
                for (int m = 0; m < 4; ++m)
#pragma unroll
                    for (int n = 0; n < 2; ++n) acc[a][b][m][n] = (f32x4){0.f, 0.f, 0.f, 0.f};
        cur = nxt; cA = nA; cB = nB; ++ui;
        if (wr == 1) PG8_BAR;
    }
    PG8_WAIT_V(0);
    PG8_BAR;
#undef PG8_SA
#undef PG8_SB
#undef PG8_STAGE
#undef PG8_LDA
#undef PG8_LDB
#undef PG8_MMA
#undef PG8_WAIT_V
#undef PG8_WAIT_L
#undef PG8_BAR
#undef PG8_SCHED
}
struct Chain3 { const bf16_t* A[3]; const bf16_t* B[3]; int K; int lda; Unit u; };
template <class EpiF>
DI void gemm_chain3(LAS unsigned char* lds, const Chain3 g, const EpiF& EF) {
    int tid_ = threadIdx.x; asm volatile("" : "+v"(tid_));
    const int tid = tid_, wid = __builtin_amdgcn_readfirstlane(tid >> 6), lane = tid & 63, wr = wid >> 2, wc = wid & 3, fr = lane & 15, fq = lane >> 4;
    unsigned voffA[2], voffB[2];
#pragma unroll
    for (int i = 0; i < 2; ++i) { int R, C; stage_rc(tid * 16 + i * 8192, R, C);
        voffA[i] = (unsigned)(R * g.lda + C) * 2u; voffB[i] = (unsigned)(R * g.K + C) * 2u; }
    const size_t kstep = (size_t)(BK * 2);
    const size_t hstepA = (size_t)128 * g.lda * 2, tstepA = 2 * hstepA;
    const size_t hstepB = (size_t)HALF * g.K * 2;
    const unsigned ldsw = (unsigned)wid * 1024u;
    const int aoff = lds_byte(wr * 64 + fr, fq * 8), boff = lds_byte(wc * 32 + fr, fq * 8);
#define PG8_SA(b, h) (((b) * 2 + (h)) * HTB)
#define PG8_SB(b, h) ((4 + (b) * 2 + (h)) * HTB)
#define PG8_STAGE(bufoff, gbase, voff) do { _Pragma("unroll") for (int _i = 0; _i < 2; ++_i) \
        __builtin_amdgcn_global_load_lds((const unsigned*)((const char*)(gbase) + (voff)[_i]), (LAS unsigned*)(lds + (bufoff) + ldsw + _i * 8192), 16, 0, 0); } while (0)
#define PG8_LDA(dst, b, h) do { _Pragma("unroll") for (int m = 0; m < 4; ++m) _Pragma("unroll") for (int k = 0; k < 2; ++k) dst[m][k] = *(const LAS bf16x8*)(lds + PG8_SA(b, h) + aoff + m * 2048 + k * 1024); } while (0)
#define PG8_LDB(dst, b, h) do { _Pragma("unroll") for (int n = 0; n < 2; ++n) _Pragma("unroll") for (int k = 0; k < 2; ++k) dst[n][k] = *(const LAS bf16x8*)(lds + PG8_SB(b, h) + boff + n * 2048 + k * 1024); } while (0)
#define PG8_MMA(ai, bj, At, Bt) do { __builtin_amdgcn_s_setprio(1); _Pragma("unroll") for (int m = 0; m < 4; ++m) _Pragma("unroll") for (int n = 0; n < 2; ++n) _Pragma("unroll") for (int k = 0; k < 2; ++k) \
        acc[ai][bj][m][n] = __builtin_amdgcn_mfma_f32_16x16x32_bf16(Bt[n][k], At[m][k], acc[ai][bj][m][n], 0, 0, 0); __builtin_amdgcn_s_setprio(0); } while (0)
#define PG8_WAIT_V(n) asm volatile("s_waitcnt vmcnt(" #n ")" ::: "memory")
#define PG8_WAIT_L(n) asm volatile("s_waitcnt lgkmcnt(" #n ")" ::: "memory")
#define PG8_BAR __builtin_amdgcn_s_barrier()
#define PG8_SCHED __builtin_amdgcn_sched_barrier(0)
    const Unit cur = g.u; int ui = 0;
    f32x4 acc[2][2][4][2];
#pragma unroll
    for (int a = 0; a < 2; ++a)
#pragma unroll
        for (int b = 0; b < 2; ++b)
#pragma unroll
            for (int m = 0; m < 4; ++m)
#pragma unroll
                for (int n = 0; n < 2; ++n) acc[a][b][m][n] = (f32x4){0.f, 0.f, 0.f, 0.f};
    bf16x8 At[4][2], B0[2][2], B1[2][2];
    const char* cA = (const char*)g.A[0] + (size_t)cur.pm * tstepA; const char* cB = (const char*)g.B[0] + (size_t)cur.pn * 2 * hstepB;
    PG8_STAGE(PG8_SB(0, 0), cB, voffB); PG8_STAGE(PG8_SB(0, 1), cB + hstepB, voffB); PG8_STAGE(PG8_SA(0, 0), cA, voffA); PG8_STAGE(PG8_SA(0, 1), cA + hstepA, voffA);
    if (wr == 1) PG8_BAR;
    PG8_WAIT_V(2); PG8_BAR;
    PG8_STAGE(PG8_SB(1, 0), cB + kstep, voffB); PG8_STAGE(PG8_SA(1, 0), cA + kstep, voffA); PG8_STAGE(PG8_SB(1, 1), cB + hstepB + kstep, voffB);
    PG8_WAIT_V(6); PG8_BAR;
    for (;;) {
        const bool has_next = ui < 2; const int un = has_next ? ui + 1 : ui;
        const bf16_t* An = un == 0 ? g.A[0] : (un == 1 ? g.A[1] : g.A[2]); const bf16_t* Bn = un == 0 ? g.B[0] : (un == 1 ? g.B[1] : g.B[2]);
        const int nt = g.K / BK;
        const char* nA = has_next ? (const char*)An + (size_t)cur.pm * tstepA : cA; const char* nB = has_next ? (const char*)Bn + (size_t)cur.pn * 2 * hstepB : cB;
        for (int t = 0; t < nt; t += 2) {
            const bool last = (t == nt - 2);
            const char* a1 = cA + (size_t)(t + 1) * kstep;
            const char* a2 = last ? nA : cA + (size_t)(t + 2) * kstep; const char* b2 = last ? nB : cB + (size_t)(t + 2) * kstep;
            const char* a3 = a2 + kstep; const char* b3 = b2 + kstep;
            PG8_LDB(B0, 0, 0); PG8_LDB(B1, 0, 1); PG8_SCHED; PG8_LDA(At, 0, 0); PG8_STAGE(PG8_SA(1, 1), a1 + hstepA, voffA);
            PG8_WAIT_V(8); PG8_WAIT_L(0); PG8_BAR; PG8_MMA(0, 0, At, B0); PG8_MMA(0, 1, At, B1); PG8_BAR; PG8_SCHED;
            PG8_LDA(At, 0, 1); PG8_STAGE(PG8_SB(0, 0), b2, voffB); PG8_STAGE(PG8_SB(0, 1), b2 + hstepB, voffB); PG8_STAGE(PG8_SA(0, 0), a2, voffA);
            PG8_WAIT_V(8); PG8_WAIT_L(0); PG8_BAR; PG8_MMA(1, 0, At, B0); PG8_MMA(1, 1, At, B1); PG8_BAR; PG8_SCHED;
            PG8_LDB(B0, 1, 0); PG8_LDB(B1, 1, 1); PG8_SCHED; PG8_LDA(At, 1, 0); PG8_STAGE(PG8_SA(0, 1), a2 + hstepA, voffA);
            PG8_WAIT_V(8); PG8_WAIT_L(0); PG8_BAR; PG8_MMA(0, 0, At, B0); PG8_MMA(0, 1, At, B1); PG8_BAR; PG8_SCHED;
            PG8_LDA(At, 1, 1); PG8_STAGE(PG8_SB(1, 0), b3, voffB); PG8_STAGE(PG8_SB(1, 1), b3 + hstepB, voffB); PG8_STAGE(PG8_SA(1, 0), a3, voffA);
            PG8_WAIT_V(8); PG8_WAIT_L(0); PG8_BAR; PG8_MMA(1, 0, At, B0); PG8_MMA(1, 1, At, B1); PG8_BAR; PG8_SCHED;
        }
        if (wr == 0) PG8_BAR;
        EF(acc, ui, cur, wr, wc, fr, fq);
        if (!has_next) break;
        cA = nA; cB = nB; ++ui;
        if (wr == 1) PG8_BAR;
    }
    PG8_WAIT_V(0);
    PG8_BAR;
#undef PG8_SA
#undef PG8_SB
#undef PG8_STAGE
#undef PG8_LDA
#undef PG8_LDB
#undef PG8_MMA
#undef PG8_WAIT_V
#undef PG8_WAIT_L
#undef PG8_BAR
#undef PG8_SCHED
}
}
using pg8::Unit;

struct Params {
    const float* x; const float* mem; const int* pos;
    const float *mix_g, *memn_g, *w_in, *aq_g, *ak_g, *dq_g, *dk_g, *eq_g, *ek_g, *w_memkv, *w_ba, *w_bd, *w_bm, *w_out, *ffn_g, *w_up, *conv_w, *conv_b, *w_down;
    float* out; unsigned char* ws;
};

struct EpiIn {
    int mode;
    bf16_t* proj; int ldp; bf16_t* gates; const float* rstd; const float* cosT; const float* sinT;
    const float *g_qa, *g_ka, *g_qd, *g_kd, *g_qm; float* kmean;
    DI void operator()(const f32x4 (&acc)[2][2][4][2], const Unit& u, int wr, int wc, int fr, int fq) const {
        const int cb = u.pn * 256 + wc * 64;
        const int row0 = u.pm * 256 + wr * 64 + fr;
        int kind; const float* gain = nullptr; float qs = 1.f; bool isk = false; bf16_t* ob = proj; int ldc = ldp; int oc = cb; int khead = 0;
        if (mode == 0) {
            if (cb < C_QM) { const int seg = cb / 384, hh = (cb - seg * 384) >> 6;
                if (seg == 0) { kind = 0; gain = g_qa; qs = C2; } else if (seg == 1) { kind = 0; gain = g_ka; isk = true; khead = hh; }
                else if (seg == 3) { kind = 0; gain = g_qd; qs = C2; } else if (seg == 4) { kind = 0; gain = g_kd; } else kind = 2;
                ob = proj + (size_t)(seg * 6 + hh) * HS; ldc = 64; oc = 0; }
            else if (cb < QKVW) { kind = 1; gain = g_qm; qs = C2; ob = proj + OFF_QM + (size_t)((cb - C_QM) >> 6) * HS; ldc = 64; oc = 0; }
            else { kind = 3; ob = gates; ldc = GW; oc = cb - QKVW; }
        } else { if (u.pn == 0) { kind = 1; gain = g_qa; } else kind = 2; }
        f32x4 gv[2][2];
#pragma unroll
        for (int bj = 0; bj < 2; ++bj)
#pragma unroll
            for (int n = 0; n < 2; ++n) gv[bj][n] = (kind <= 1) ? *(const f32x4*)(gain + 32 * bj + 8 * fq + 4 * n) : (f32x4){1.f, 1.f, 1.f, 1.f};
        f32x4 cs[2][2];
#pragma unroll
        for (int bj = 0; bj < 2; ++bj) { cs[bj][0] = (f32x4){0.f, 0.f, 0.f, 0.f}; cs[bj][1] = cs[bj][0]; }
#pragma unroll
        for (int ai = 0; ai < 2; ++ai)
#pragma unroll
            for (int m = 0; m < 4; ++m) {
                const int row = row0 + ai * 128 + m * 16;
                const float rs = rstd ? rstd[row] : 1.f;
                f32x4 v[2][2];
#pragma unroll
                for (int bj = 0; bj < 2; ++bj)
#pragma unroll
                    for (int n = 0; n < 2; ++n) v[bj][n] = acc[ai][bj][m][n] * ((kind == 3) ? rs * -1.4426950408889634f : rs);
                if (kind <= 1) {
                    float ss = 0.f;
#pragma unroll
                    for (int bj = 0; bj < 2; ++bj)
#pragma unroll
                        for (int n = 0; n < 2; ++n) { const f32x4 t = v[bj][n]; ss += (t[0] * t[0] + t[1] * t[1]) + (t[2] * t[2] + t[3] * t[3]); }
                    ss += __shfl_xor(ss, 16); ss += __shfl_xor(ss, 32);
                    const float inv = rsqrtf(ss * (1.f / 64.f) + EPS);
#pragma unroll
                    for (int bj = 0; bj < 2; ++bj)
#pragma unroll
                        for (int n = 0; n < 2; ++n) v[bj][n] = v[bj][n] * inv * gv[bj][n];
                    if (kind == 0) {
#pragma unroll
                        for (int n = 0; n < 2; ++n) {
                            const f32x4 c = *(const f32x4*)(cosT + (size_t)row * 32 + 8 * fq + 4 * n), s = *(const f32x4*)(sinT + (size_t)row * 32 + 8 * fq + 4 * n);
                            const f32x4 x1 = v[0][n], x2 = v[1][n];
                            v[0][n] = x1 * c - x2 * s; v[1][n] = x1 * s + x2 * c;
                        }
                    }
#pragma unroll
                    for (int bj = 0; bj < 2; ++bj)
#pragma unroll
                        for (int n = 0; n < 2; ++n) v[bj][n] = v[bj][n] * qs;
                    if (isk) {
#pragma unroll
                        for (int bj = 0; bj < 2; ++bj)
#pragma unroll
                            for (int n = 0; n < 2; ++n) cs[bj][n] += v[bj][n];
                    }
                } else if (kind == 3) {
#pragma unroll
                    for (int bj = 0; bj < 2; ++bj)
#pragma unroll
                        for (int n = 0; n < 2; ++n)
#pragma unroll
                            for (int j = 0; j < 4; ++j) v[bj][n][j] = fmaxf(__builtin_amdgcn_rcpf(1.f + __builtin_amdgcn_exp2f(v[bj][n][j])), 1e-20f);
                }
                bf16_t* rp = ob + (size_t)row * ldc + oc + 8 * fq;
#pragma unroll
                for (int bj = 0; bj < 2; ++bj) { u32x4 w; w.x = pk2(v[bj][0][0], v[bj][0][1]); w.y = pk2(v[bj][0][2], v[bj][0][3]); w.z = pk2(v[bj][1][0], v[bj][1][1]); w.w = pk2(v[bj][1][2], v[bj][1][3]);
                    *(u32x4*)(rp + 32 * bj) = w; }
            }
        if (isk && kmean) {
#pragma unroll
            for (int bj = 0; bj < 2; ++bj)
#pragma unroll
                for (int n = 0; n < 2; ++n)
#pragma unroll
                    for (int j = 0; j < 4; ++j) { float t = cs[bj][n][j]; t += __shfl_xor(t, 1); t += __shfl_xor(t, 2); t += __shfl_xor(t, 4); t += __shfl_xor(t, 8);
                        if (fr == 0) atomicAdd(kmean + ((size_t)(khead * 64 + u.pm) * 64 + 32 * bj + 8 * fq + 4 * n + j), t * (1.f / 256.f)); }
        }
    }
};

struct EpiGate {
    bf16_t* merged; const bf16_t* gates; int gi; int first;
    DI void operator()(const f32x4 (&acc)[2][2][4][2], const Unit& u, int wr, int wc, int fr, int fq) const {
        const int row0 = u.pm * 256 + wr * 64 + fr, col = u.pn * 256 + wc * 64 + 8 * fq;
#pragma unroll
        for (int ai = 0; ai < 2; ++ai)
#pragma unroll
            for (int m = 0; m < 4; ++m) { const int row = row0 + ai * 128 + m * 16;
#pragma unroll
                for (int bj = 0; bj < 2; ++bj) {
                    const u32x4 g = *(const u32x4*)(gates + (size_t)row * GW + gi * 1024 + col + 32 * bj);
                    bf16_t* mp = merged + (size_t)row * DM + col + 32 * bj;
                    float o[8];
                    o[0] = acc[ai][bj][m][0][0] * bf_lo(g.x); o[1] = acc[ai][bj][m][0][1] * bf_hi(g.x); o[2] = acc[ai][bj][m][0][2] * bf_lo(g.y); o[3] = acc[ai][bj][m][0][3] * bf_hi(g.y);
                    o[4] = acc[ai][bj][m][1][0] * bf_lo(g.z); o[5] = acc[ai][bj][m][1][1] * bf_hi(g.z); o[6] = acc[ai][bj][m][1][2] * bf_lo(g.w); o[7] = acc[ai][bj][m][1][3] * bf_hi(g.w);
                    if (!first) { const u32x4 p = *(const u32x4*)mp;
                        o[0] += bf_lo(p.x); o[1] += bf_hi(p.x); o[2] += bf_lo(p.y); o[3] += bf_hi(p.y); o[4] += bf_lo(p.z); o[5] += bf_hi(p.z); o[6] += bf_lo(p.w); o[7] += bf_hi(p.w); }
                    u32x4 w; w.x = pk2(o[0], o[1]); w.y = pk2(o[2], o[3]); w.z = pk2(o[4], o[5]); w.w = pk2(o[6], o[7]);
                    *(u32x4*)mp = w; } }
    }
};

struct EpiGate3 { bf16_t* merged_; const bf16_t* gates_;
    DI void operator()(f32x4 (&acc)[2][2][4][2], int i, const Unit& u, int wr, int wc, int fr, int fq) const {
        const int row0 = u.pm * 256 + wr * 64 + fr, col = u.pn * 256 + wc * 64 + 8 * fq;
#pragma unroll
        for (int ai = 0; ai < 2; ++ai)
#pragma unroll
            for (int m = 0; m < 4; ++m) { const int row = row0 + ai * 128 + m * 16;
#pragma unroll
                for (int bj = 0; bj < 2; ++bj) {
                    const bf16_t* gp = gates_ + (size_t)row * GW + i * 1024 + col + 32 * bj;
                    const u32x4 ga = *(const u32x4*)gp;
#define G_LO(w) bf_lo(w)
#define G_HI(w) bf_hi(w)
                    if (i < 2) { const u32x4 gb = *(const u32x4*)(gp + 1024);
                        acc[ai][bj][m][0][0] *= G_LO(ga.x) * __builtin_amdgcn_rcpf(G_LO(gb.x)); acc[ai][bj][m][0][1] *= G_HI(ga.x) * __builtin_amdgcn_rcpf(G_HI(gb.x));
                        acc[ai][bj][m][0][2] *= G_LO(ga.y) * __builtin_amdgcn_rcpf(G_LO(gb.y)); acc[ai][bj][m][0][3] *= G_HI(ga.y) * __builtin_amdgcn_rcpf(G_HI(gb.y));
                        acc[ai][bj][m][1][0] *= G_LO(ga.z) * __builtin_amdgcn_rcpf(G_LO(gb.z)); acc[ai][bj][m][1][1] *= G_HI(ga.z) * __builtin_amdgcn_rcpf(G_HI(gb.z));
                        acc[ai][bj][m][1][2] *= G_LO(ga.w) * __builtin_amdgcn_rcpf(G_LO(gb.w)); acc[ai][bj][m][1][3] *= G_HI(ga.w) * __builtin_amdgcn_rcpf(G_HI(gb.w));
                    } else {
                        u32x4 w;
                        w.x = pk2(acc[ai][bj][m][0][0] * G_LO(ga.x), acc[ai][bj][m][0][1] * G_HI(ga.x)); w.y = pk2(acc[ai][bj][m][0][2] * G_LO(ga.y), acc[ai][bj][m][0][3] * G_HI(ga.y));
                        w.z = pk2(acc[ai][bj][m][1][0] * G_LO(ga.z), acc[ai][bj][m][1][1] * G_HI(ga.z)); w.w = pk2(acc[ai][bj][m][1][2] * G_LO(ga.w), acc[ai][bj][m][1][3] * G_HI(ga.w));
                        *(u32x4*)(merged_ + (size_t)row * DM + col + 32 * bj) = w; }
#undef G_LO
#undef G_HI
                    asm volatile("" ::: "memory");
                } }
    }
};

struct EpiRes1 {
    const float* x; float* x1; bf16_t* x1b; float* ssq;
    DI void operator()(const f32x4 (&acc)[2][2][4][2], const Unit& u, int wr, int wc, int fr, int fq) const {
        const int row0 = u.pm * 256 + wr * 64 + fr, col = u.pn * 256 + wc * 64 + 8 * fq;
#pragma unroll
        for (int ai = 0; ai < 2; ++ai)
#pragma unroll
            for (int m = 0; m < 4; ++m) { const int row = row0 + ai * 128 + m * 16; float ss = 0.f;
#pragma unroll
                for (int bj = 0; bj < 2; ++bj) { f32x4 v[2];
#pragma unroll
                    for (int n = 0; n < 2; ++n) { const size_t off = (size_t)row * DM + col + 32 * bj + 4 * n; v[n] = *(const f32x4*)(x + off) + acc[ai][bj][m][n];
                        ss += (v[n][0] * v[n][0] + v[n][1] * v[n][1]) + (v[n][2] * v[n][2] + v[n][3] * v[n][3]); }
                    u32x4 w; w.x = pk2(v[0][0], v[0][1]); w.y = pk2(v[0][2], v[0][3]); w.z = pk2(v[1][0], v[1][1]); w.w = pk2(v[1][2], v[1][3]);
                    *(u32x4*)(x1b + (size_t)row * DM + col + 32 * bj) = w; }
                ss += __shfl_xor(ss, 16); ss += __shfl_xor(ss, 32);
                if (fq == 0) ssq[(size_t)row * 16 + u.pn * 4 + wc] = ss; }
    }
};

struct EpiRes2 {
    float* out; const bf16_t* x1b; int store;
    DI void operator()(const f32x4 (&acc)[2][2][4][2], const Unit& u, int wr, int wc, int fr, int fq) const {
        const int row0 = u.pm * 256 + wr * 64 + fr, col = u.pn * 256 + wc * 64 + 8 * fq;
#pragma unroll
        for (int ai = 0; ai < 2; ++ai)
#pragma unroll
            for (int m = 0; m < 4; ++m) { const int row = row0 + ai * 128 + m * 16;
#pragma unroll
                for (int bj = 0; bj < 2; ++bj) { const size_t off = (size_t)row * DM + col + 32 * bj; const u32x4 r = *(const u32x4*)(x1b + off);
                    f32x4 v0 = acc[ai][bj][m][0], v1 = acc[ai][bj][m][1];
                    v0[0] += bf_lo(r.x); v0[1] += bf_hi(r.x); v0[2] += bf_lo(r.y); v0[3] += bf_hi(r.y); v1[0] += bf_lo(r.z); v1[1] += bf_hi(r.z); v1[2] += bf_lo(r.w); v1[3] += bf_hi(r.w);
                    if (store) { *(f32x4*)(out + off) = v0; *(f32x4*)(out + off + 4) = v1; } } }
    }
};

DI float dpp_ror1(float v) { return __builtin_bit_cast(float, __builtin_amdgcn_update_dpp(0, __builtin_bit_cast(int, v), 0x121, 0xf, 0xf, false)); }
DI float dpp_ror2(float v) { return __builtin_bit_cast(float, __builtin_amdgcn_update_dpp(0, __builtin_bit_cast(int, v), 0x122, 0xf, 0xf, false)); }

struct EpiConv {
    bf16_t* act; const float* ssq; const float* cw; const float* cbias;
    DI void operator()(const f32x4 (&acc)[2][2][4][2], const Unit& u, int wr, int wc, int fr, int fq) const {
        const int ca = u.pn * 128 + wc * 32 + 8 * fq;
#pragma unroll
        for (int ai = 0; ai < 2; ++ai) {
            const int tok0 = u.pm * 248 + 62 * (2 * ai + wr) + 4 * fr - 2;
            float rs[4];
#pragma unroll
            for (int m = 0; m < 4; ++m) { const int tok = tok0 + m; float r = 0.f;
                const bool okr = (tok >= 0 && tok < S);
                const f32x4 a = okr ? *(const f32x4*)(ssq + (size_t)tok * 16 + 4 * fq) : (f32x4){0.f, 0.f, 0.f, 0.f};
                float t = (a[0] + a[1]) + (a[2] + a[3]); t += __shfl_xor(t, 16); t += __shfl_xor(t, 32);
                if (okr) r = rsqrtf(t * (1.f / 1024.f) + EPS);
                rs[m] = r; }
            __builtin_amdgcn_sched_barrier(0);
            unsigned pkd[4][4];
#pragma unroll
            for (int n = 0; n < 2; ++n) {
                f32x4 w0[2], w1[2], w2[2], bb[2];
#pragma unroll
                for (int bj = 0; bj < 2; ++bj) { const int c = bj * FF + ca + 4 * n;
                    w0[bj] = *(const f32x4*)(cw + c); w1[bj] = *(const f32x4*)(cw + 2 * FF + c); w2[bj] = *(const f32x4*)(cw + 4 * FF + c); bb[bj] = *(const f32x4*)(cbias + c); }
                asm volatile("" : "+v"(w0[0]), "+v"(w1[0]), "+v"(w2[0]), "+v"(bb[0]), "+v"(w0[1]), "+v"(w1[1]), "+v"(w2[1]), "+v"(bb[1]));
#pragma unroll
                for (int jp = 0; jp < 2; ++jp) {
                    float av[4][2];
#pragma unroll
                    for (int jj = 0; jj < 2; ++jj) { const int j = 2 * jp + jj;
                        float y[2][4];
#pragma unroll
                        for (int bj = 0; bj < 2; ++bj) {
                            float X[4], t2, t3;
#pragma unroll
                            for (int m = 0; m < 4; ++m) X[m] = acc[ai][bj][m][n][j] * rs[m];
                            asm volatile("s_nop 1\n\t"
                                         "v_mov_b32_dpp %0, %2 row_shr:1 row_mask:0xf bank_mask:0xf\n\t"
                                         "v_mov_b32_dpp %1, %3 row_shr:1 row_mask:0xf bank_mask:0xf"
                                         : "=&v"(t2), "=&v"(t3) : "v"(X[2]), "v"(X[3]));
                            const float a0 = w0[bj][j], a1 = w1[bj][j], a2 = w2[bj][j], bv = bb[bj][j];
                            y[bj][0] = bv + a0 * t2 + a1 * t3 + a2 * X[0];
                            y[bj][1] = bv + a0 * t3 + a1 * X[0] + a2 * X[1];
                            y[bj][2] = bv + a0 * X[0] + a1 * X[1] + a2 * X[2];
                            y[bj][3] = bv + a0 * X[1] + a1 * X[2] + a2 * X[3];
                        }
#pragma unroll
                        for (int m = 0; m < 4; ++m) { const float gt = y[0][m]; av[m][jj] = gt * __builtin_amdgcn_rcpf(1.f + __expf(-gt)) * y[1][m];
                            asm volatile("" : "+v"(av[m][jj])); }
                    }
#pragma unroll
                    for (int m = 0; m < 4; ++m) { pkd[m][2 * n + jp] = pk2(av[m][0], av[m][1]); asm volatile("" : "+v"(pkd[m][2 * n + jp])); }
                    __builtin_amdgcn_sched_barrier(0);
                }
                asm volatile("" ::: "memory");
            }
#pragma unroll
            for (int m = 0; m < 4; ++m) { const int tok = tok0 + m;
                if ((4 * fr + m) >= 2 && tok < S) { u32x4 w; w.x = pkd[m][0]; w.y = pkd[m][1]; w.z = pkd[m][2]; w.w = pkd[m][3]; *(u32x4*)(act + (size_t)tok * FF + ca) = w; } }
        }
    }
};

DI int perm_generic(int c) { const int u = c >> 8, cl = c & 255, wc = cl >> 6, bj = (cl >> 5) & 1, fq = (cl >> 3) & 3, n = (cl >> 2) & 1, j = cl & 3; return (u << 8) + 128 * bj + 32 * wc + 16 * n + 4 * fq + j; }
DI int perm_up(int c) { const int bj = c >= FF ? 1 : 0, a = c - FF * bj, pn = a >> 7, al = a & 127, wc = al >> 5, fq = (al >> 3) & 3, n = (al >> 2) & 1, j = al & 3; return (pn << 8) + 128 * bj + 32 * wc + 16 * n + 4 * fq + j; }
DI float wave_sum(float v) {
#pragma unroll
    for (int o = 1; o < 64; o <<= 1) v += __shfl_xor(v, o);
    return v; }
DI float wave_max(float v) {
#pragma unroll
    for (int o = 1; o < 64; o <<= 1) v = fmaxf(v, __shfl_xor(v, o));
    return v; }
DI void p0_transpose_item(const float* W, int K, int N, const float* gain, bf16_t* WT, int up, LAS float* scr, int item, int lane, int ldt = 0) {
    const int nblk = N / 32, kb = item / nblk, nb = item % nblk, k0 = 64 * kb, n0 = 32 * nb;
    const int c4 = lane & 7, r0 = lane >> 3;
    f32x4 w[8];
#pragma unroll
    for (int i = 0; i < 8; ++i) w[i] = *(const f32x4*)(W + (size_t)(k0 + r0 + 8 * i) * N + n0 + 4 * c4);
#pragma unroll
    for (int i = 0; i < 8; ++i) { const int kk = r0 + 8 * i; f32x4 v = w[i]; if (gain) v = v * gain[k0 + kk];
        LAS float* d = scr + kk * 33 + 4 * c4; d[0] = v[0]; d[1] = v[1]; d[2] = v[2]; d[3] = v[3]; }
    asm volatile("s_waitcnt lgkmcnt(0)" ::: "memory");
    const int c = lane & 7;
#pragma unroll
    for (int j = 0; j < 4; ++j) { const int n = (lane >> 3) + 8 * j; const LAS float* s = scr + (8 * c) * 33 + n;
        u32x4 o; o.x = pk2(s[0 * 33], s[1 * 33]); o.y = pk2(s[2 * 33], s[3 * 33]); o.z = pk2(s[4 * 33], s[5 * 33]); o.w = pk2(s[6 * 33], s[7 * 33]);
        const int rowp = up ? perm_up(n0 + n) : perm_generic(n0 + n);
        *(u32x4*)(WT + (size_t)rowp * (ldt ? ldt : K) + k0 + 8 * c) = o; }
    asm volatile("s_waitcnt lgkmcnt(0)" ::: "memory");
}

#define MFMA32(a, b, c) __builtin_amdgcn_mfma_f32_32x32x16_bf16((a), (b), (c), 0, 0, 0)
DI int crow(int i, int h) { return (i & 3) + 8 * (i >> 2) + 4 * h; }
DI s16x4 vtr(const LAS unsigned char* p) { return __builtin_bit_cast(s16x4, __builtin_amdgcn_ds_read_tr16_b64_v4i16((LAS s16x4*)p)); }
constexpr int KP = 144;

DI void pv_tile(const float (&p)[16], const LAS unsigned char* vt, f32x16 (&o)[2], int lane) {
    const int h = lane >> 5, i16 = lane & 15, q = i16 >> 2, pp = i16 & 3, blk = (lane >> 4) & 1;
    bf16x8 pb[2];
#pragma unroll
    for (int sp = 0; sp < 2; ++sp) { u32x4 w; w.x = pk2(p[8 * sp + 0], p[8 * sp + 1]); w.y = pk2(p[8 * sp + 2], p[8 * sp + 3]); w.z = pk2(p[8 * sp + 4], p[8 * sp + 5]); w.w = pk2(p[8 * sp + 6], p[8 * sp + 7]); pb[sp] = __builtin_bit_cast(bf16x8, w); }
#pragma unroll
    for (int dh = 0; dh < 2; ++dh)
#pragma unroll
        for (int sp = 0; sp < 2; ++sp) {
            const LAS unsigned char* a0 = vt + (16 * sp + 4 * h + q) * KP + 2 * (32 * dh + 16 * blk) + 8 * pp;
            const s16x4 lo = vtr(a0), hi = vtr(a0 + 8 * KP);
            const bf16x8 vf = __builtin_shufflevector(lo, hi, 0, 1, 2, 3, 4, 5, 6, 7);
            o[dh] = MFMA32(vf, pb[sp], o[dh]);
        }
}

DI float softmax_bound(const float* gq, const float* gk, int lane) { const float a = wave_max(fabsf(gq[lane])), b = wave_max(fabsf(gk[lane])); const float r = 64.f * a * b * C2;
    return __builtin_bit_cast(float, __builtin_amdgcn_readfirstlane(__builtin_bit_cast(int, r))); }

struct BAUnit { const bf16_t* Kg; const bf16_t* Vg; int kpitch; const bf16_t* Q; int qpitch; int q0; const unsigned* list; int count; int head; int nvalid; bf16_t* O; int opitch; };
struct BAPref { u32x4 k[4], v[4]; bf16x8 qf[4]; unsigned ent; int qrow; bool valid; };
template <int MODE>
DI void ba_issue(BAPref& f, const BAUnit& u, int tid, int wave, int r32, int h) {
#pragma unroll
    for (int i = 0; i < 4; ++i) { const int c = tid + 512 * i, row = c >> 3, cc = c & 7;
        f.k[i] = *(const u32x4*)(u.Kg + (size_t)row * u.kpitch + 8 * cc); f.v[i] = *(const u32x4*)(u.Vg + (size_t)row * u.kpitch + 8 * cc); }
    f.ent = 0u; f.valid = true;
    if (MODE == 1) { const int idx = 32 * wave + r32; f.valid = idx < u.count; f.ent = f.valid ? u.list[idx] : 0u; f.qrow = (int)(f.ent >> 2); }
    else f.qrow = u.q0 + 32 * wave + r32;
#pragma unroll
    for (int s = 0; s < 4; ++s) f.qf[s] = *(const bf16x8*)(u.Q + (size_t)f.qrow * u.qpitch + 16 * s + 8 * h);
}
template <int MODE, class NextF>
DI void block_attn_loop(LAS unsigned char* lds, const NextF& next, float negM, bf16_t* slotO, float* slotL, bool do_store) {
    int tid_ = threadIdx.x; asm volatile("" : "+v"(tid_));
    const int tid = tid_, lane = tid & 63, wave = __builtin_amdgcn_readfirstlane(tid >> 6), r32 = lane & 31, h = lane >> 5;
    LAS unsigned char* Kl = lds; LAS unsigned char* Vl = lds + 256 * KP;
    BAUnit cur, nxt; int ui = 0;
    if (!next(0, cur)) return;
    BAPref f; ba_issue<MODE>(f, cur, tid, wave, r32, h);
    f32x16 negm;
#pragma unroll
    for (int i = 0; i < 16; ++i) negm[i] = negM;
    for (;;) {
#pragma unroll
        for (int i = 0; i < 4; ++i) { const int c = tid + 512 * i, row = c >> 3, cc = c & 7;
            *(LAS u32x4*)(Kl + row * KP + 16 * cc) = f.k[i]; *(LAS u32x4*)(Vl + row * KP + 16 * cc) = f.v[i]; }
        bf16x8 qf[4];
#pragma unroll
        for (int s = 0; s < 4; ++s) qf[s] = f.qf[s];
        const unsigned ent = f.ent; const int qrow = f.qrow; const bool valid = f.valid;
        asm volatile("" : "+v"(qf[0]), "+v"(qf[1]), "+v"(qf[2]), "+v"(qf[3]));
        __syncthreads();
        const bool has_next = next(ui + 1, nxt);
        if (has_next) ba_issue<MODE>(f, nxt, tid, wave, r32, h);
        f32x16 o[2]; float l = 0.f;
#pragma unroll
        for (int i = 0; i < 16; ++i) { o[0][i] = 0.f; o[1][i] = 0.f; }
        const int ntile = (MODE == 2) ? wave + 1 : 8;
#pragma unroll 2
        for (int kt = 0; kt < ntile; ++kt) {
            f32x16 sacc = negm;
#pragma unroll
            for (int s = 0; s < 4; ++s) { const bf16x8 kf = *(const LAS bf16x8*)(Kl + (32 * kt + r32) * KP + 2 * (16 * s + 8 * h)); sacc = MFMA32(kf, qf[s], sacc); }
            float p[16];
#pragma unroll
            for (int i = 0; i < 16; ++i) { float e = __builtin_amdgcn_exp2f(sacc[i]); if (MODE == 2) { if (kt == wave && crow(i, h) > r32) e = 0.f; } p[i] = e; l += e; }
            pv_tile(p, Vl + 32 * kt * KP, o, lane);
        }
        l += __shfl_xor(l, 32);
        if (MODE == 1) {
            if (valid) { const int slot = (int)(ent & 3u); const size_t sb = ((size_t)qrow * 6 + cur.head) * 3 + slot;
#pragma unroll
                for (int dh = 0; dh < 2; ++dh)
#pragma unroll
                    for (int g = 0; g < 4; ++g) { u32x2 w; w.x = pk2(o[dh][4 * g], o[dh][4 * g + 1]); w.y = pk2(o[dh][4 * g + 2], o[dh][4 * g + 3]); *(u32x2*)(slotO + sb * 64 + 32 * dh + 8 * g + 4 * h) = w; }
                if (h == 0) slotL[sb] = l; }
        } else {
            if (MODE == 2) {
                for (int sl = 0; sl < cur.nvalid; ++sl) { const size_t sb = ((size_t)qrow * 6 + cur.head) * 3 + sl;
#pragma unroll
                    for (int dh = 0; dh < 2; ++dh)
#pragma unroll
                        for (int g = 0; g < 4; ++g) { const u32x2 w = *(const u32x2*)(slotO + sb * 64 + 32 * dh + 8 * g + 4 * h);
                            o[dh][4 * g] += bf_lo(w.x); o[dh][4 * g + 1] += bf_hi(w.x); o[dh][4 * g + 2] += bf_lo(w.y); o[dh][4 * g + 3] += bf_hi(w.y); }
                    l += slotL[sb]; }
            }
            const float il = __builtin_amdgcn_rcpf(l);
            if (do_store)
#pragma unroll
            for (int dh = 0; dh < 2; ++dh)
#pragma unroll
                for (int g = 0; g < 4; ++g) { u32x2 w; w.x = pk2(o[dh][4 * g] * il, o[dh][4 * g + 1] * il); w.y = pk2(o[dh][4 * g + 2] * il, o[dh][4 * g + 3] * il);
                    *(u32x2*)(cur.O + (size_t)qrow * cur.opitch + 32 * dh + 8 * g + 4 * h) = w; }
        }
        __syncthreads();
        if (!has_next) break;
        cur = nxt; ++ui;
    }
}

struct DilState { int r, g, sh, kb0, kstep, ntile, qpos, t0, lim, koff, vcol; int voff[4]; bf16x8 qf[4]; bf16x8 kfn[4]; u32x4 vn[4]; };
DI void dil_load(DilState& s, const bf16_t* Kh, const bf16_t* Vh, int T, int h) {
    const int kb_ = s.kb0 + s.kstep * T; int kp_ = kb_ + s.koff; kp_ = kp_ < 0 ? 0 : kp_;
#pragma unroll
    for (int q = 0; q < 4; ++q) s.kfn[q] = *(const bf16x8*)(Kh + (size_t)kp_ * 64 + 16 * q + 8 * h);
#pragma unroll
    for (int i = 0; i < 4; ++i) { int vp_ = kb_ + s.voff[i]; vp_ = vp_ < 0 ? 0 : vp_; s.vn[i] = *(const u32x4*)(Vh + (size_t)vp_ * 64 + s.vcol); }
}
DI void dil_setup(DilState& s, int pi, const bf16_t* Qh, const bf16_t* Kh, const bf16_t* Vh, int P0, int lane, int wave) {
    const int r32 = lane & 31, h = lane >> 5;
    s.r = pi == 0 ? 1 : (pi == 1 ? 4 : 16); s.g = pi == 2 ? 2 : 1; s.sh = s.g - 1;
    int qb;
    if (pi == 0) { qb = P0 + 32 * wave; s.kb0 = qb - 128; s.kstep = 32; s.ntile = 5; }
    else if (pi == 1) { qb = P0 + (wave >> 1) + 128 * (wave & 1); s.kb0 = qb - 512; s.kstep = 128; s.ntile = 5; }
    else { qb = P0 + 2 * wave; s.kb0 = qb - 2048; s.kstep = 256; s.ntile = 9; }
    s.qpos = qb + (r32 & (s.g - 1)) + s.r * (r32 >> s.sh);
#pragma unroll
    for (int q = 0; q < 4; ++q) s.qf[q] = *(const bf16x8*)(Qh + (size_t)s.qpos * 64 + 16 * q + 8 * h);
    const int maxoff = (s.g - 1) + s.r * (31 >> s.sh);
    int t0 = 0; while (t0 < s.ntile && s.kb0 + s.kstep * t0 + maxoff < 0) ++t0;
    s.t0 = t0;
    s.lim = min(128 * s.r, s.qpos);
    s.koff = (r32 & (s.g - 1)) + s.r * (r32 >> s.sh);
#pragma unroll
    for (int i = 0; i < 4; ++i) { const int row = (lane >> 3) + 8 * i; s.voff[i] = (row & (s.g - 1)) + s.r * (row >> s.sh); }
    s.vcol = 8 * (lane & 7);
    if (t0 < s.ntile) dil_load(s, Kh, Vh, t0, h);
}
DI void dil_run(DilState& s, const bf16_t* Kh, const bf16_t* Vh, LAS unsigned char* vst0, const float negM, f32x16 (&o)[2], float& l, int lane) {
    const int h = lane >> 5;
    int offi[16];
#pragma unroll
    for (int i = 0; i < 16; ++i) { const int row = crow(i, h); offi[i] = (row & (s.g - 1)) + s.r * (row >> s.sh); }
#pragma unroll
    for (int i = 0; i < 16; ++i) { o[0][i] = 0.f; o[1][i] = 0.f; }
    l = 0.f;
#pragma unroll 2
    for (int t = s.t0; t < s.ntile; ++t) {
        LAS unsigned char* vst = vst0 + (t & 1) * (32 * KP);
        bf16x8 kf[4]; u32x4 vv[4];
#pragma unroll
        for (int q = 0; q < 4; ++q) { kf[q] = s.kfn[q]; vv[q] = s.vn[q]; }
        asm volatile("" : "+v"(kf[0]), "+v"(kf[1]), "+v"(kf[2]), "+v"(kf[3]));
        asm volatile("" : "+v"(vv[0]), "+v"(vv[1]), "+v"(vv[2]), "+v"(vv[3]));
        if (t + 1 < s.ntile) dil_load(s, Kh, Vh, t + 1, h);
#pragma unroll
        for (int i = 0; i < 4; ++i) *(LAS u32x4*)(vst + ((lane >> 3) + 8 * i) * KP + 2 * s.vcol) = vv[i];
        f32x16 sacc;
#pragma unroll
        for (int i = 0; i < 16; ++i) sacc[i] = 0.f;
#pragma unroll
        for (int q = 0; q < 4; ++q) sacc = MFMA32(kf[q], s.qf[q], sacc);
        const int dq = s.qpos - (s.kb0 + s.kstep * t);
        float p[16];
#pragma unroll
        for (int i = 0; i < 16; ++i) { const int d = dq - offi[i];
            const bool ok = ((unsigned)d <= (unsigned)s.lim) && ((d & (s.r - 1)) == 0);
            const float e = ok ? __builtin_amdgcn_exp2f(sacc[i] + negM) : 0.f; p[i] = e; l += e; }
        pv_tile(p, vst, o, lane);
    }
    l += __shfl_xor(l, 32);
}
DI void dil_accum(LAS float* accl, bool first, int ql, const f32x16 (&o)[2], float l, int h) {
    if (first) {
#pragma unroll
        for (int dh = 0; dh < 2; ++dh)
#pragma unroll
            for (int i = 0; i < 16; ++i) accl[ql * 65 + 32 * dh + crow(i, h)] = o[dh][i];
        if (h == 0) accl[ql * 65 + 64] = l;
    } else {
#pragma unroll
        for (int dh = 0; dh < 2; ++dh)
#pragma unroll
            for (int i = 0; i < 16; ++i) accl[ql * 65 + 32 * dh + crow(i, h)] += o[dh][i];
        if (h == 0) accl[ql * 65 + 64] += l;
    }
}
DI void dilated_unit(LAS unsigned char* lds, const bf16_t* proj, bf16_t* aout, int hd, int P0, float negM, bool do_store = true) {
    int tid_ = threadIdx.x; asm volatile("" : "+v"(tid_));
    const int tid = tid_, lane = tid & 63, wave = __builtin_amdgcn_readfirstlane(tid >> 6), h = lane >> 5;
    LAS float* accl = (LAS float*)lds;
    LAS unsigned char* vst0 = lds + 256 * 65 * 4 + wave * (2 * 32 * KP);
    const bf16_t* Qh = proj + OFF_QD + (size_t)hd * HS; const bf16_t* Kh = proj + OFF_KD + (size_t)hd * HS; const bf16_t* Vh = proj + OFF_VD + (size_t)hd * HS;
    DilState A, B; f32x16 o[2]; float l;
    dil_setup(A, 0, Qh, Kh, Vh, P0, lane, wave);
    dil_run(A, Kh, Vh, vst0, negM, o, l, lane);
    dil_setup(B, 1, Qh, Kh, Vh, P0, lane, wave);
    dil_accum(accl, true, A.qpos - P0, o, l, h);
    __syncthreads();
    dil_run(B, Kh, Vh, vst0, negM, o, l, lane);
    dil_setup(A, 2, Qh, Kh, Vh, P0, lane, wave);
    dil_accum(accl, false, B.qpos - P0, o, l, h);
    __syncthreads();
    dil_run(A, Kh, Vh, vst0, negM, o, l, lane);
    dil_accum(accl, false, A.qpos - P0, o, l, h);
    __syncthreads();
    if (do_store) { const int ql = tid >> 1, half = tid & 1; const float il = 1.f / accl[ql * 65 + 64];
        bf16_t* op = aout + (size_t)(P0 + ql) * DM + 384 + hd * 64 + 32 * half;
#pragma unroll
        for (int c = 0; c < 4; ++c) { float v[8];
#pragma unroll
            for (int e = 0; e < 8; ++e) v[e] = accl[ql * 65 + 32 * half + 8 * c + e] * il;
            u32x4 w; w.x = pk2(v[0], v[1]); w.y = pk2(v[2], v[3]); w.z = pk2(v[4], v[5]); w.w = pk2(v[6], v[7]); *(u32x4*)(op + 8 * c) = w; } }
    __syncthreads();
}

DI void top3_insert(float v, int idx, float& b0, float& b1, float& b2, int& i0, int& i1, int& i2) {
    const bool c0 = (v > b0) || (v == b0 && idx < i0), c1 = (v > b1) || (v == b1 && idx < i1), c2 = (v > b2) || (v == b2 && idx < i2);
    const float nb2 = c1 ? b1 : (c2 ? v : b2); const int ni2 = c1 ? i1 : (c2 ? idx : i2);
    const float nb1 = c0 ? b0 : (c1 ? v : b1); const int ni1 = c0 ? i0 : (c1 ? idx : i1);
    const float nb0 = c0 ? v : b0; const int ni0 = c0 ? idx : i0;
    b0 = nb0; b1 = nb1; b2 = nb2; i0 = ni0; i1 = ni1; i2 = ni2;
}
DI void select_unit(LAS unsigned char* lds, const bf16_t* proj, const float* kmean, unsigned* cnt, unsigned* lists, int hd, int n, bool do_store = true) {
    int tid_ = threadIdx.x; asm volatile("" : "+v"(tid_));
    const int tid = tid_, lane = tid & 63, wave = __builtin_amdgcn_readfirstlane(tid >> 6), r32 = lane & 31, h = lane >> 5;
    LAS unsigned char* Khi = lds; LAS unsigned char* Klo = lds + 64 * KP;
    LAS unsigned* hist = (LAS unsigned*)(lds + 32768);
    { const int row = tid >> 3, c8 = tid & 7; const float* kp = kmean + ((size_t)hd * 64 + row) * 64 + 8 * c8;
      const f32x4 x0 = *(const f32x4*)kp, x1 = *(const f32x4*)(kp + 4);
      u32x4 hv, lv;
      hv.x = pk2(x0[0], x0[1]); lv.x = pk2(x0[0] - bf_lo(hv.x), x0[1] - bf_hi(hv.x));
      hv.y = pk2(x0[2], x0[3]); lv.y = pk2(x0[2] - bf_lo(hv.y), x0[3] - bf_hi(hv.y));
      hv.z = pk2(x1[0], x1[1]); lv.z = pk2(x1[0] - bf_lo(hv.z), x1[1] - bf_hi(hv.z));
      hv.w = pk2(x1[2], x1[3]); lv.w = pk2(x1[2] - bf_lo(hv.w), x1[3] - bf_hi(hv.w));
      *(LAS u32x4*)(Khi + row * KP + 16 * c8) = hv;
      *(LAS u32x4*)(Klo + row * KP + 16 * c8) = lv; }
    if (tid < 128) hist[tid] = 0u;
    const int q = 256 * n + 32 * wave + r32;
    bf16x8 qf[4];
#pragma unroll
    for (int s = 0; s < 4; ++s) qf[s] = *(const bf16x8*)(proj + OFF_QA + (size_t)hd * HS + (size_t)q * 64 + 16 * s + 8 * h);
    __syncthreads();
    f32x16 g0, g1;
#pragma unroll
    for (int i = 0; i < 16; ++i) { g0[i] = 0.f; g1[i] = 0.f; }
#pragma unroll
    for (int s = 0; s < 4; ++s) { const int co = 2 * (16 * s + 8 * h);
        const bf16x8 a0 = *(const LAS bf16x8*)(Khi + r32 * KP + co), a1 = *(const LAS bf16x8*)(Klo + r32 * KP + co);
        const bf16x8 c0 = *(const LAS bf16x8*)(Khi + (32 + r32) * KP + co), c1 = *(const LAS bf16x8*)(Klo + (32 + r32) * KP + co);
        g0 = MFMA32(a0, qf[s], g0); g0 = MFMA32(a1, qf[s], g0); g1 = MFMA32(c0, qf[s], g1); g1 = MFMA32(c1, qf[s], g1); }
    float b0 = -INFINITY, b1 = -INFINITY, b2 = -INFINITY; int i0 = -1, i1 = -1, i2 = -1;
#pragma unroll
    for (int i = 0; i < 16; ++i) { const int blk = crow(i, h); const bool okb = blk < n; top3_insert(okb ? g0[i] : -INFINITY, okb ? blk : 1000, b0, b1, b2, i0, i1, i2); }
#pragma unroll
    for (int i = 0; i < 16; ++i) { const int blk = 32 + crow(i, h); const bool okb = blk < n; top3_insert(okb ? g1[i] : -INFINITY, okb ? blk : 1000, b0, b1, b2, i0, i1, i2); }
    {
        const float ob0 = __shfl_xor(b0, 32), ob1 = __shfl_xor(b1, 32), ob2 = __shfl_xor(b2, 32); const int oi0 = __shfl_xor(i0, 32), oi1 = __shfl_xor(i1, 32), oi2 = __shfl_xor(i2, 32);
        top3_insert(oi0 >= 0 ? ob0 : -INFINITY, oi0 >= 0 ? oi0 : 1000, b0, b1, b2, i0, i1, i2);
        top3_insert(oi1 >= 0 ? ob1 : -INFINITY, oi1 >= 0 ? oi1 : 1000, b0, b1, b2, i0, i1, i2);
        top3_insert(oi2 >= 0 ? ob2 : -INFINITY, oi2 >= 0 ? oi2 : 1000, b0, b1, b2, i0, i1, i2);
    }
    unsigned lr0 = 0u, lr1 = 0u, lr2 = 0u;
    if (h == 0) {
        if (i0 >= 0) lr0 = __hip_atomic_fetch_add(hist + i0, 1u, __ATOMIC_RELAXED, __HIP_MEMORY_SCOPE_WORKGROUP);
        if (i1 >= 0) lr1 = __hip_atomic_fetch_add(hist + i1, 1u, __ATOMIC_RELAXED, __HIP_MEMORY_SCOPE_WORKGROUP);
        if (i2 >= 0) lr2 = __hip_atomic_fetch_add(hist + i2, 1u, __ATOMIC_RELAXED, __HIP_MEMORY_SCOPE_WORKGROUP);
    }
    __syncthreads();
    if (tid < n) { const unsigned c = hist[tid]; hist[64 + tid] = (c && do_store) ? atomicAdd(cnt + hd * 64 + tid, c) : 0u; }
    __syncthreads();
    if (h == 0 && do_store) {
        unsigned* lh = lists + (size_t)hd * LIST_PER_HEAD;
        if (i0 >= 0) lh[list_off(i0) + hist[64 + i0] + lr0] = ((unsigned)q << 2) | 0u;
        if (i1 >= 0) lh[list_off(i1) + hist[64 + i1] + lr1] = ((unsigned)q << 2) | 1u;
        if (i2 >= 0) lh[list_off(i2) + hist[64 + i2] + lr2] = ((unsigned)q << 2) | 2u;
    }
    __syncthreads();
}

struct OneBA { BAUnit u0; DI bool operator()(int i, BAUnit& u) const { if (i) return false; u = u0; return true; } };
struct MemNext { bf16_t* mkv_; bf16_t* proj_; bf16_t* ao_; int e0, stride, n;
    DI bool operator()(int i, BAUnit& u) const { const int e = e0 + stride * i; if (e >= n) return false; const int hm = e >> 6, qt = e & 63;
        u.Kg = mkv_ + hm * 64; u.Vg = mkv_ + 256 + hm * 64; u.kpitch = 512; u.Q = proj_ + OFF_QM + (size_t)hm * HS; u.qpitch = 64; u.q0 = qt * 256; u.list = nullptr; u.count = 0; u.head = 0; u.nvalid = 0; u.O = ao_ + 768 + hm * 64; u.opitch = DM; return true; } };
struct GathNext { LAS int* pre; int T, bx, G; const unsigned* cnt_; bf16_t* proj_; const unsigned* lists_;
    DI bool operator()(int i, BAUnit& u) const { const int ui = bx + i * G; if (ui >= T) return false;
        int e, t, c;
        if (i < 16) { e = pre[512 + 3 * i]; t = pre[513 + 3 * i]; c = pre[514 + 3 * i]; }
        else { int lo = 0, hi = 377; while (lo < hi) { const int mid = (lo + hi) >> 1; if (pre[mid] > ui) hi = mid; else lo = mid + 1; }
               e = lo; t = ui - (e ? pre[e - 1] : 0); c = (int)cnt_[(e / 63) * 64 + e % 63]; }
        const int hd = e / 63, n = e % 63;
        u.Kg = proj_ + OFF_KA + (size_t)hd * HS + (size_t)(256 * n) * 64; u.Vg = proj_ + OFF_VA + (size_t)hd * HS + (size_t)(256 * n) * 64; u.kpitch = 64; u.Q = proj_ + OFF_QA + (size_t)hd * HS; u.qpitch = 64; u.q0 = 0; u.O = nullptr; u.opitch = 0;
        u.list = lists_ + (size_t)hd * LIST_PER_HEAD + list_off(n) + 256 * t; u.count = c - 256 * t; u.head = hd; u.nvalid = 0; return true; } };
struct OwnNext { int bx, G; bf16_t* proj_; bf16_t* ao_;
    DI bool operator()(int i, BAUnit& u) const { const int ui = bx + i * G; if (ui >= 6 * 64) return false; const int hd = ui >> 6, n = 63 - (ui & 63);
        u.Kg = proj_ + OFF_KA + (size_t)hd * HS + (size_t)(256 * n) * 64; u.Vg = proj_ + OFF_VA + (size_t)hd * HS + (size_t)(256 * n) * 64; u.kpitch = 64; u.Q = proj_ + OFF_QA + (size_t)hd * HS; u.qpitch = 64; u.q0 = 256 * n; u.O = ao_ + hd * 64; u.opitch = DM;
        u.list = nullptr; u.count = 0; u.head = hd; u.nvalid = n < 3 ? n : 3; return true; } };

#define XB_TMO      128
#define XB_XCNT(j)  (256  + 64 * (j))
#define XB_XSUB(j)  (1280 + 64 * (j))
#define XB_XGEN(j)  (2304 + 64 * (j))
#define XB_TOP      3328
#define XB_TOPGEN   3392
#define XCD_BAR_WORDS 3456
#define XB_SPIN_CAP (1u << 18)
DI unsigned xb_ld(unsigned* p)              { return __hip_atomic_load(p, __ATOMIC_RELAXED, __HIP_MEMORY_SCOPE_AGENT); }
DI unsigned xb_add(unsigned* p, unsigned v) { return __hip_atomic_fetch_add(p, v, __ATOMIC_RELAXED, __HIP_MEMORY_SCOPE_AGENT); }
DI unsigned xb_xcc_id() { return (unsigned)__builtin_amdgcn_s_getreg((3 << 11) | 20) & 0xFu; }
#define XB_SPIN(cond, bar) do { unsigned _sp = 0; while (cond) { __builtin_amdgcn_s_sleep(1); \
    if ((++_sp & 255u) == 0u) { if (xb_ld(&(bar)[XB_TMO])) break; if (_sp > XB_SPIN_CAP) { atomicAdd(&(bar)[XB_TMO], 1u); break; } } } } while (0)
struct XcdBarrier { unsigned* bar; unsigned x; volatile LAS unsigned* st; };
DI XcdBarrier xcd_barrier_post(unsigned* bar, volatile LAS unsigned* st) {
    XcdBarrier b; b.bar = bar; b.x = xb_xcc_id(); b.st = st;
    if (threadIdx.x == 0) (void)xb_add(&bar[XB_XCNT(b.x)], 1u);
    return b;
}
DI void xcd_barrier_complete(unsigned* bar, unsigned x, unsigned& nloc, unsigned& nx) {
    const unsigned G = gridDim.x * gridDim.y * gridDim.z;
    unsigned sum, cnt_, mine, sp = 0u;
    for (;;) {
        sum = 0u; cnt_ = 0u; mine = 0u;
#pragma unroll
        for (unsigned j = 0; j < 16; ++j) { const unsigned c = xb_ld(&bar[XB_XCNT(j)]); sum += c; cnt_ += (c > 0u) ? 1u : 0u; mine = (j == x) ? c : mine; }
        if (sum == G) break;
        __builtin_amdgcn_s_sleep(1);
        if ((++sp & 255u) == 0u) { if (xb_ld(&bar[XB_TMO])) break; if (sp > XB_SPIN_CAP) { atomicAdd(&bar[XB_TMO], 1u); break; } }
    }
    nloc = mine > 0u ? mine : 1u; nx = cnt_ > 0u ? cnt_ : 1u;
}
DI void xcd_barrier(const XcdBarrier& b) {
    asm volatile("s_waitcnt vmcnt(0)" ::: "memory");
    __syncthreads();
    if (threadIdx.x == 0) {
        unsigned* bar = b.bar;
        __builtin_amdgcn_s_waitcnt(0);
        unsigned nloc = b.st[0], nx = b.st[1];
        if (nloc == 0u) { xcd_barrier_complete(bar, b.x, nloc, nx); b.st[0] = nloc; b.st[1] = nx; }
        const unsigned old = xb_add(&bar[XB_XSUB(b.x)], 1u);
        const unsigned gen = old / nloc;
        if (old + 1u == (gen + 1u) * nloc) {
            __builtin_amdgcn_fence(__ATOMIC_RELEASE, "agent");
            asm volatile("s_waitcnt vmcnt(0)" ::: "memory");
            const unsigned og = xb_add(&bar[XB_TOP], 1u);
            const unsigned tg = og / nx;
            if (og + 1u == (tg + 1u) * nx) xb_add(&bar[XB_TOPGEN], 1u);
            else XB_SPIN(xb_ld(&bar[XB_TOPGEN]) == tg, bar);
            __builtin_amdgcn_fence(__ATOMIC_ACQUIRE, "agent");
            xb_add(&bar[XB_XGEN(b.x)], 1u);
            asm volatile("s_waitcnt vmcnt(0)" ::: "memory");
        } else {
            XB_SPIN(xb_ld(&bar[XB_XGEN(b.x)]) == gen, bar);
            __builtin_amdgcn_fence(__ATOMIC_ACQUIRE, "agent");
            asm volatile("s_waitcnt vmcnt(0)" ::: "memory");
        }
    }
    __syncthreads();
}

DI int ltid() { int t = threadIdx.x; asm volatile("" : "+v"(t)); return t; }
typedef const __attribute__((address_space(4))) Params* KParams;
DI KParams kpar() { KParams q = (KParams)__builtin_amdgcn_kernarg_segment_ptr(); asm volatile("" : "+s"(q)); return q; }
DI unsigned char* wsb_() { unsigned char* w = kpar()->ws; asm volatile("" : "+s"(w)); return w; }
DI unsigned char* outb_() { unsigned char* w = (unsigned char*)kpar()->out; asm volatile("" : "+s"(w)); return w; }
#define wsb(p_) wsb_()
#define outb(p_) outb_()
#define XBAR_NOW (XcdBarrier{(unsigned*)(wsb_() + WS_CTL + CTL_BAR), xb_xcc_id(), (volatile LAS unsigned*)(lds + LDS_BYTES - 64)})
#define p (*kpar())
__global__ void __launch_bounds__(512, 2) fwd_megakernel(Params p_arg) {
    extern __shared__ __attribute__((aligned(16))) unsigned char lds_raw[];
    LAS unsigned char* lds = (LAS unsigned char*)lds_raw;
    cg::grid_group grid = cg::this_grid();
    const int G = gridDim.x, bx = blockIdx.x;
    { const int tid = threadIdx.x;
    if (tid < 4) ((volatile LAS unsigned*)(lds + LDS_BYTES - 64))[tid] = 0u;
    __syncthreads();
    }
    (void)xcd_barrier_post((unsigned*)(p.ws + WS_CTL + CTL_BAR), (volatile LAS unsigned*)(lds + LDS_BYTES - 64));
    unsigned char* ws = p.ws;
#define cnt ((unsigned*)(wsb(p) + WS_CTL + CTL_CNT))
#define kmean ((float*)(wsb(p) + WS_CTL + CTL_KMEAN))
#define rstd1 ((float*)(wsb(p) + WS_RSTD1))
#define ssq2 ((float*)(wsb(p) + WS_SSQ2))
#define cosT ((float*)(wsb(p) + WS_COS))
#define sinT ((float*)(wsb(p) + WS_SIN))
#define memn ((bf16_t*)(wsb(p) + WS_MEMN))
#define mkv ((bf16_t*)(wsb(p) + WS_MKV))
#define w_in_t ((bf16_t*)(wsb(p) + WS_WIN))
#define w_up_t ((bf16_t*)(wsb(p) + WS_WUP))
#define w_down_t ((bf16_t*)(wsb(p) + WS_WDOWN))
#define w_out_t ((bf16_t*)(wsb(p) + WS_WOUT))
#define w_ba_t ((bf16_t*)(wsb(p) + WS_WBA))
#define w_bd_t ((bf16_t*)(wsb(p) + WS_WBD))
#define w_bm_t ((bf16_t*)(wsb(p) + WS_WBM))
#define w_mkv_t ((bf16_t*)(wsb(p) + WS_WMKV))
#define xb ((bf16_t*)(wsb(p) + WS_XB))
#define merged ((bf16_t*)(wsb(p) + WS_PROJ))
#define attn_out ((bf16_t*)(wsb(p) + WS_XB))
#define proj ((bf16_t*)(wsb(p) + WS_PROJ))
#define x1b ((bf16_t*)(wsb(p) + WS_XB))
#define gates ((bf16_t*)(wsb(p) + WS_GATES))
#define act ((bf16_t*)(wsb(p) + WS_GATES))
#define slotO ((bf16_t*)(outb(p) + DO_SLOTO))
#define slotL ((float*)(outb(p) + DO_SLOTL))
#define lists ((unsigned*)(outb(p) + DO_LIST))

    for (int rep_ = 0; rep_ < REP_P0; ++rep_) {
    {
        const int tid = ltid(), lane = tid & 63, wave = __builtin_amdgcn_readfirstlane(tid >> 6); (void)lane; (void)wave;
        LAS float* scr = (LAS float*)(lds + wave * 16384);
        const int gw = bx * 8 + wave, NGW = G * 8;
        constexpr int I_IN = 16 * 176, I_MKV = 16 * 16;
        for (int it = gw; it < I_IN + I_MKV; it += NGW) {
            if (it < I_IN) p0_transpose_item(p.w_in, DM, INC, p.mix_g, w_in_t, 0, scr, it, lane);
            else p0_transpose_item(p.w_memkv, DM, 512, nullptr, w_mkv_t, 0, scr, it - I_IN, lane);
        }
        for (int m0 = 2 * gw; m0 < S + NMEM; m0 += 2 * NGW) {
            f32x4 v[2][4]; float s[2];
#pragma unroll
            for (int q = 0; q < 2; ++q) { const int m = m0 + q; const float* src_ = (m >= S) ? p.mem + (size_t)(m - S) * DM : p.x + (size_t)m * DM;
                const f32x4* xr = (const f32x4*)src_ + lane;
#pragma unroll
                for (int j = 0; j < 4; ++j) v[q][j] = xr[64 * j]; }
#pragma unroll
            for (int q = 0; q < 2; ++q) { float t = 0.f;
#pragma unroll
                for (int j = 0; j < 4; ++j) t += (v[q][j][0] * v[q][j][0] + v[q][j][1] * v[q][j][1]) + (v[q][j][2] * v[q][j][2] + v[q][j][3] * v[q][j][3]);
                s[q] = t; }
#pragma unroll
            for (int q = 0; q < 2; ++q) { const int m = m0 + q; const bool ismem = m >= S;
                const float rstd = rsqrtf(wave_sum(s[q]) * (1.f / DM) + EPS);
                bf16_t* dst = ismem ? memn + (size_t)(m - S) * DM : xb + (size_t)m * DM;
                if (ismem) {
#pragma unroll
                    for (int j = 0; j < 4; ++j) { const f32x4 gg = *((const f32x4*)p.memn_g + lane + 64 * j); v[q][j] = v[q][j] * rstd * gg; }
                } else if (lane == 0) rstd1[m] = rstd;
#pragma unroll
                for (int j = 0; j < 4; ++j) { u32x2 w; w.x = pk2(v[q][j][0], v[q][j][1]); w.y = pk2(v[q][j][2], v[q][j][3]); *((u32x2*)dst + lane + 64 * j) = w; } }
        }
        { const float inv_freq = powf(10000.f, -(float)(tid & 31) / 32.f);
          for (int i = bx * 512 + tid; i < S * 32; i += G * 512) { const int t = i >> 5;
            const float ang = (float)p.pos[t] * inv_freq; float sn, cs; sincosf(ang, &sn, &cs);
            cosT[i] = cs; sinT[i] = sn; } }
        for (int i = bx * 512 + tid; i < (int)((CTL_KMEAN + 6 * 64 * 64 * 4) / 4); i += G * 512) ((unsigned*)(wsb_() + WS_CTL))[i] = 0u;
    }
    if (gridDim.y > 1) grid.sync();
    xcd_barrier(XBAR_NOW);

    }
    for (int rep_ = 0; rep_ < REP_P1; ++rep_) {
    {
        const int tid = ltid(), lane = tid & 63, wave = __builtin_amdgcn_readfirstlane(tid >> 6); (void)lane; (void)wave;
        pg8::Gemm g{xb, w_in_t, S, INC, DM, DM, 0}; pg8::StaticOrder So; So.init(S, INC, G, bx);
        EpiIn E{0, proj, QKVW, gates, rstd1, cosT, sinT, p.aq_g, p.ak_g, p.dq_g, p.dk_g, p.eq_g, (rep_ == REP_P1 - 1) ? kmean : nullptr};
        pg8::gemm_phase<EpiIn, pg8::StaticOrder>(lds, g, So, E);
        pg8::Gemm g2{memn, w_mkv_t, NMEM, 512, DM, DM, 0}; pg8::OneUnit O1; O1.have = (bx >= G - 2) ? 1 : 0; O1.u0.pm = 0; O1.u0.pn = bx - (G - 2);
        EpiIn E2{1, mkv, 512, nullptr, nullptr, nullptr, nullptr, p.ek_g, nullptr, nullptr, nullptr, nullptr, nullptr};
        pg8::gemm_phase<EpiIn, pg8::OneUnit>(lds, g2, O1, E2);
    }
    xcd_barrier(XBAR_NOW);

    }
    for (int rep_ = 0; rep_ < REP_P2; ++rep_) {
    {
        const int tid = ltid(), lane = tid & 63, wave = __builtin_amdgcn_readfirstlane(tid >> 6); (void)lane; (void)wave;
        const float negD = -softmax_bound(p.dq_g, p.dk_g, lane), negE = -softmax_bound(p.eq_g, p.ek_g, lane);
        constexpr int NU_D = 6 * 64, NU_E = 4 * 64, NU_S = 6 * 63;
        const bool last_rep = (rep_ == REP_P2 - 1);
        if (G == 256) {
            const int xc = bx & 7, xi = bx >> 3, vb = xc * 32 + xi, li = xc * 16 + (xi >> 1);
            dilated_unit(lds, proj, attn_out, vb >> 6, (vb & 63) * 256, negD, last_rep);
            if (!(xi & 1)) { const int ui = 256 + li; dilated_unit(lds, proj, attn_out, ui >> 6, (ui & 63) * 256, negD, last_rep); }
            else {
                { MemNext mn{mkv, proj, attn_out, li, 128, NU_E}; block_attn_loop<0>(lds, mn, negE, nullptr, nullptr, last_rep); }
                for (int e = li; e < NU_S; e += 128) { const int hd = e / 63, n = 1 + e % 63; select_unit(lds, proj, kmean, cnt, lists, hd, n, last_rep); }
            }
        } else
        for (int ui = bx; ui < NU_D + NU_E + NU_S; ui += G) {
            if (ui < NU_D) { dilated_unit(lds, proj, attn_out, ui >> 6, (ui & 63) * 256, negD, last_rep); }
            else if (ui < NU_D + NU_E) { MemNext mn{mkv, proj, attn_out, ui - NU_D, 1 << 20, NU_E}; block_attn_loop<0>(lds, mn, negE, nullptr, nullptr, last_rep); }
            else { const int e = ui - NU_D - NU_E, hd = e / 63, n = 1 + e % 63; select_unit(lds, proj, kmean, cnt, lists, hd, n, last_rep); }
        }
    }
    xcd_barrier(XBAR_NOW);
    }
    for (int rep_ = 0; rep_ < REP_P3; ++rep_) {
    {
        const int tid = ltid(), lane = tid & 63, wave = __builtin_amdgcn_readfirstlane(tid >> 6); (void)lane; (void)wave;
        const float negA = -softmax_bound(p.aq_g, p.ak_g, lane);
        LAS int* pre = (LAS int*)(lds + 81920);
        { int v = 0; if (tid < 378) { const int hd = tid / 63, n = tid % 63; v = ((int)cnt[hd * 64 + n] + 255) >> 8; }
          pre[tid] = v; __syncthreads();
          for (int off = 1; off < 512; off <<= 1) { const int a = (tid >= off) ? pre[tid - off] : 0; __syncthreads(); pre[tid] += a; __syncthreads(); } }
        const int T = pre[377];
        const int vb = (G == 256) ? (bx & 7) * 32 + (bx >> 3) : bx;
        if (tid < 16) { const int ui = vb + tid * G;
            if (ui < T) { int lo = 0, hi = 377; while (lo < hi) { const int mid = (lo + hi) >> 1; if (pre[mid] > ui) hi = mid; else lo = mid + 1; }
                pre[512 + 3 * tid] = lo; pre[513 + 3 * tid] = ui - (lo ? pre[lo - 1] : 0); pre[514 + 3 * tid] = (int)cnt[(lo / 63) * 64 + lo % 63]; } }
        __syncthreads();
        { GathNext gn{pre, T, vb, G, cnt, proj, lists}; block_attn_loop<1>(lds, gn, negA, slotO, slotL, true); }
    }
    xcd_barrier(XBAR_NOW);

    }
    for (int rep_ = 0; rep_ < REP_P3B; ++rep_) {
    {
        const int tid = ltid(), lane = tid & 63, wave = __builtin_amdgcn_readfirstlane(tid >> 6); (void)lane; (void)wave;
        const float negA = -softmax_bound(p.aq_g, p.ak_g, lane);
        {
            constexpr int I_UP = 16 * 176, I_DN = 44 * 32, I_OUT = 16 * 32, I_BA = 6 * 32, I_BD = 6 * 32, I_BM = 4 * 32, NIT2 = I_UP + I_DN + I_OUT + I_BA + I_BD + I_BM;
            LAS float* scr = (LAS float*)(lds + wave * 16384);
            const int nw = (G > 128) ? (G - 128) * 8 : G * 8, w0 = (G > 128) ? (bx - 128) * 8 + wave : bx * 8 + wave;
            if (G <= 128 || bx >= 128)
            for (int it = w0; it < NIT2; it += nw) {
                int r = it;
                if (r < I_UP) { p0_transpose_item(p.w_up, DM, INC, p.ffn_g, w_up_t, 1, scr, r, lane); continue; } r -= I_UP;
                if (r < I_DN) { p0_transpose_item(p.w_down, FF, DM, nullptr, w_down_t, 0, scr, r, lane); continue; } r -= I_DN;
                if (r < I_OUT) { p0_transpose_item(p.w_out, DM, DM, nullptr, w_out_t, 0, scr, r, lane); continue; } r -= I_OUT;
                if (r < I_BA) { p0_transpose_item(p.w_ba, 384, DM, nullptr, w_ba_t, 0, scr, r, lane); continue; } r -= I_BA;
                if (r < I_BD) { p0_transpose_item(p.w_bd, 384, DM, nullptr, w_bd_t, 0, scr, r, lane); continue; } r -= I_BD;
                p0_transpose_item(p.w_bm, 256, DM, nullptr, w_bm_t, 0, scr, r, lane, 384);
            }
            if (G <= 128 || bx >= 128) for (int i = w0 * 64 + lane; i < 1024 * 16; i += nw * 64) { const int rw = i >> 4, cc = i & 15; *(u32x4*)(w_bm_t + (size_t)rw * 384 + 256 + 8 * cc) = (u32x4){0u, 0u, 0u, 0u}; }
            __syncthreads();
        }
        { OwnNext on{bx, G, proj, attn_out}; block_attn_loop<2>(lds, on, negA, slotO, slotL, rep_ == REP_P3B - 1); }
    }
    xcd_barrier(XBAR_NOW);

    }
    for (int rep_ = 0; rep_ < REP_P4; ++rep_) {
    {
        const int tid = ltid(), lane = tid & 63, wave = __builtin_amdgcn_readfirstlane(tid >> 6); (void)lane; (void)wave;
        pg8::StaticOrder So; So.init(S, DM, G, bx);
        for (int i = 0; ; ++i) { pg8::Unit u; if (!So.next(i, u)) break;
            pg8::Chain3 g; g.A[0] = attn_out; g.A[1] = attn_out + 384; g.A[2] = attn_out + 768; g.B[0] = w_ba_t; g.B[1] = w_bd_t; g.B[2] = w_bm_t; g.K = 384; g.lda = DM; g.u = u;
            EpiGate3 E{merged, gates}; pg8::gemm_chain3<EpiGate3>(lds, g, E); }
    }
    xcd_barrier(XBAR_NOW);

    }
    for (int rep_ = 0; rep_ < REP_P5; ++rep_) {
    {
        const int tid = ltid(), lane = tid & 63, wave = __builtin_amdgcn_readfirstlane(tid >> 6); (void)lane; (void)wave;
        if (bx == 0) { for (int i = tid; i < 1024; i += 512) ((unsigned*)(ws + WS_XB - 4096))[i] = 0u; }
        pg8::Gemm g{merged, w_out_t, S, DM, DM, DM, 0}; pg8::StaticOrder So; So.init(S, DM, G, bx);
        EpiRes1 E{p.x, p.out, x1b, ssq2}; pg8::gemm_phase<EpiRes1, pg8::StaticOrder>(lds, g, So, E);
    }
    xcd_barrier(XBAR_NOW);

    }
    for (int rep_ = 0; rep_ < REP_P6; ++rep_) {
    {
        const int tid = ltid(), lane = tid & 63, wave = __builtin_amdgcn_readfirstlane(tid >> 6); (void)lane; (void)wave;
        pg8::Gemm g{x1b - 2 * DM, w_up_t, 67 * 256, INC, DM, DM, 1}; pg8::StaticOrder So; So.init(67 * 256, INC, G, bx);
        EpiConv E{act, ssq2, p.conv_w, p.conv_b}; pg8::gemm_phase<EpiConv, pg8::StaticOrder>(lds, g, So, E);
    }
    xcd_barrier(XBAR_NOW);

    }
    for (int rep_ = 0; rep_ < REP_P7; ++rep_) {
    {
        const int tid = ltid(), lane = tid & 63, wave = __builtin_amdgcn_readfirstlane(tid >> 6); (void)lane; (void)wave;
        pg8::Gemm g{act, w_down_t, S, DM, FF, FF, 0}; pg8::StaticOrder So; So.init(S, DM, G, bx);
        EpiRes2 E{p.out, x1b, rep_ == REP_P7 - 1 ? 1 : 0}; pg8::gemm_phase<EpiRes2, pg8::StaticOrder>(lds, g, So, E);
    }
    if (rep_ + 1 < REP_P7) xcd_barrier(XBAR_NOW);
    }
}

#undef p
extern "C" void kernel_launch(void* const* d_in, const int* in_sizes, int n_in, void* d_out, int out_size, void* d_ws, size_t ws_size, hipStream_t stream) {
    static int grid = 0;
    if (grid == 0) {
        if (n_in != 22 || ws_size < WS_END) { fprintf(stderr, "kernel_launch: unexpected inputs (n_in %d, ws %zu)\n", n_in, ws_size); grid = -1; return; }
        int dev = 0, cus = 0, per_cu = 0;
        hipGetDevice(&dev); hipDeviceGetAttribute(&cus, hipDeviceAttributeMultiprocessorCount, dev);
        hipFuncSetAttribute((const void*)fwd_megakernel, hipFuncAttributeMaxDynamicSharedMemorySize, LDS_BYTES);
        hipOccupancyMaxActiveBlocksPerMultiprocessor(&per_cu, (const void*)fwd_megakernel, 512, LDS_BYTES);
        if (per_cu < 1) per_cu = 1;
        grid = cus * 1;
        (void)hipGetLastError();
    }
    if (grid < 0) return;
    hipMemsetAsync((char*)d_ws + WS_CTL + CTL_BAR, 0, 16384, stream);
    Params p{};
    p.x = (const float*)d_in[0]; p.mem = (const float*)d_in[1]; p.pos = (const int*)d_in[2];
    p.mix_g = (const float*)d_in[3]; p.memn_g = (const float*)d_in[4]; p.w_in = (const float*)d_in[5];
    p.aq_g = (const float*)d_in[6]; p.ak_g = (const float*)d_in[7]; p.dq_g = (const float*)d_in[8]; p.dk_g = (const float*)d_in[9];
    p.eq_g = (const float*)d_in[10]; p.ek_g = (const float*)d_in[11]; p.w_memkv = (const float*)d_in[12];
    p.w_ba = (const float*)d_in[13]; p.w_bd = (const float*)d_in[14]; p.w_bm = (const float*)d_in[15]; p.w_out = (const float*)d_in[16];
    p.ffn_g = (const float*)d_in[17]; p.w_up = (const float*)d_in[18]; p.conv_w = (const float*)d_in[19]; p.conv_b = (const float*)d_in[20]; p.w_down = (const float*)d_in[21];
    p.out = (float*)d_out; p.ws = (unsigned char*)d_ws;
    void* args[] = {&p};
    hipError_t e = hipLaunchCooperativeKernel((const void*)fwd_megakernel, dim3(grid), dim3(512), args, LDS_BYTES, stream);
    if (e != hipSuccess) fprintf(stderr, "cooperative launch failed: %s (grid %d)\n", hipGetErrorString(e), grid);
}
```
